# Optimizing an MI355X kernel written in HIP

```python
import jax, jax.numpy as jnp
from jax import lax
import numpy as np

D_MODEL = 1024
BATCH = 2
SEQ = 16384
DEPTH = 1
DEC_BATCH = 16
DEC_SEQ = 32
PAST_LEN = 2048

CHUNK = 64
BAND_CHUNKS = 8
A_WINDOW = BAND_CHUNKS * CHUNK
N_HEADS_A = 8
HEAD_DIM_A = 64
WIDTH_A = N_HEADS_A * HEAD_DIM_A
REL_CLIP = 256
N_HEADS_B = 4
KEY_DIM_B = 64
VAL_DIM_B = 128
WIDTH_BK = N_HEADS_B * KEY_DIM_B
WIDTH_BV = N_HEADS_B * VAL_DIM_B
GATE_RANK = 16
GATE_TAU = 16.0
GLA_BLOCK = 16
N_MEM = 256
N_HEADS_MEM = 4
HEAD_DIM_MEM = D_MODEL // N_HEADS_MEM
D_FF = -(-(8 * D_MODEL) // (3 * 256)) * 256
MIX_WIDTH = WIDTH_A + WIDTH_BV
IN_SIZES = (WIDTH_A, WIDTH_A, WIDTH_A, WIDTH_BK, WIDTH_BK, WIDTH_BV, GATE_RANK, WIDTH_BV)
IN_OFFSETS = tuple(int(v) for v in np.cumsum(IN_SIZES)[:-1])
IN_WIDTH = sum(IN_SIZES)
EPS = 1e-6

kernel_name = "hybrid_chunkband_gla_stream_step"


def rmsnorm(x, g):
    xf = x.astype(jnp.float32)
    y = xf * lax.rsqrt(jnp.mean(xf * xf, axis=-1, keepdims=True) + EPS)
    return (y * g.astype(jnp.float32)).astype(x.dtype)


def mix_inputs(h, w_in, w_alpha2, b_alpha):
    n, t = h.shape[:2]
    qa, ka, va, qb, kb, vb, g_low, r = jnp.split(h @ w_in, IN_OFFSETS, axis=-1)
    heads_a = lambda z: z.reshape(n, t, N_HEADS_A, HEAD_DIM_A)
    z = (g_low @ w_alpha2 + b_alpha).astype(jnp.float32)
    log_a = (jax.nn.log_sigmoid(z) / GATE_TAU).reshape(n, t, N_HEADS_B, KEY_DIM_B)
    return (heads_a(qa), heads_a(ka), heads_a(va),
            qb.reshape(n, t, N_HEADS_B, KEY_DIM_B), kb.reshape(n, t, N_HEADS_B, KEY_DIM_B),
            vb.reshape(n, t, N_HEADS_B, VAL_DIM_B), log_a, r)


def rel_bias_block(table, n_q, n_k, offset):
    dist = offset + jnp.arange(n_q)[:, None] - jnp.arange(n_k)[None, :]
    idx = jnp.clip(dist, -REL_CLIP, REL_CLIP) + REL_CLIP
    return table[:, idx]


def band_attention(q, k, v, bias, valid):
    s = jnp.einsum('...qhd,...khd->...hqk', q, k).astype(jnp.float32) * (HEAD_DIM_A ** -0.5)
    s = jnp.where(valid, s + bias.astype(jnp.float32), -1e30)
    p = jax.nn.softmax(s, axis=-1).astype(v.dtype)
    return jnp.einsum('...hqk,...khd->...qhd', p, v)


def chunk_band_prompt(qa, ka, va, table):
    b, s = qa.shape[:2]
    nc = s // CHUNK
    shp = (b, nc, CHUNK, N_HEADS_A, HEAD_DIM_A)
    qc = qa.reshape(shp)
    pad = ((0, 0), (BAND_CHUNKS, 0), (0, 0), (0, 0), (0, 0))
    kp = jnp.pad(ka.reshape(shp), pad)
    vp = jnp.pad(va.reshape(shp), pad)
    n_band = (BAND_CHUNKS + 1) * CHUNK
    kband = jnp.stack([kp[:, o:o + nc] for o in range(BAND_CHUNKS + 1)], axis=2).reshape(b, nc, n_band, N_HEADS_A, HEAD_DIM_A)
    vband = jnp.stack([vp[:, o:o + nc] for o in range(BAND_CHUNKS + 1)], axis=2).reshape(b, nc, n_band, N_HEADS_A, HEAD_DIM_A)
    chunk_ok = (jnp.arange(nc)[:, None] + jnp.arange(BAND_CHUNKS + 1)[None, :] - BAND_CHUNKS) >= 0
    valid = jnp.repeat(chunk_ok, CHUNK, axis=1)[None, :, None, None, :]
    bias = rel_bias_block(table, CHUNK, n_band, A_WINDOW)
    o = band_attention(qc, kband, vband, bias, valid)
    return o.reshape(b, s, N_HEADS_A, HEAD_DIM_A)


def chunk_band_sample(qa, ka, va, cache_k, cache_v, table):
    t = qa.shape[1]
    l = cache_k.shape[1]
    k_all = jnp.concatenate([cache_k.astype(ka.dtype), ka], axis=1)
    v_all = jnp.concatenate([cache_v.astype(va.dtype), va], axis=1)
    bias = rel_bias_block(table, t, l + t, l)
    valid = jnp.ones((l + t,), dtype=bool)
    return band_attention(qa, k_all, v_all, bias, valid)


def gla_recurrence(q, k, v, log_a, s0, block):
    f32 = jnp.float32
    n, t, h, dk = q.shape
    dv = v.shape[-1]
    nb = t // block
    qb = (q.astype(f32) * (dk ** -0.5)).reshape(n, nb, block, h, dk)
    kb = k.astype(f32).reshape(n, nb, block, h, dk)
    vb = v.astype(f32).reshape(n, nb, block, h, dv)
    bcum = jnp.cumsum(log_a.astype(f32).reshape(n, nb, block, h, dk), axis=2)
    b_last = bcum[:, :, -1]
    causal = jnp.tril(jnp.ones((block, block), dtype=bool))
    diff = bcum[:, :, :, None] - bcum[:, :, None, :]
    w = jnp.exp(jnp.where(causal[:, :, None, None], diff, -jnp.inf))
    scores = jnp.einsum('nbihd,nbjhd,nbijhd->nbhij', qb, kb, w)
    o_intra = jnp.einsum('nbhij,nbjhv->nbihv', scores, vb)
    k_dec = kb * jnp.exp(b_last[:, :, None] - bcum)
    ds = jnp.einsum('nbjhd,nbjhv->nbhdv', k_dec, vb)
    decay = jnp.exp(b_last)

    def step(s, inp):
        dec, d = inp
        return dec[..., None] * s + d, s

    s_final, s_starts = lax.scan(step, s0.astype(f32), (jnp.moveaxis(decay, 1, 0), jnp.moveaxis(ds, 1, 0)))
    s_starts = jnp.moveaxis(s_starts, 0, 1)
    o_inter = jnp.einsum('nbihd,nbhdv->nbihv', qb * jnp.exp(bcum), s_starts)
    return (o_intra + o_inter).reshape(n, t, h, dv), s_final


def mix_output(o_a, o_b, r, g_gla, w_o):
    n, t = r.shape[:2]
    ob = o_b * lax.rsqrt(jnp.mean(o_b * o_b, axis=-1, keepdims=True) + EPS)
    y_b = ob.reshape(n, t, WIDTH_BV) * g_gla.astype(jnp.float32) * jax.nn.silu(r.astype(jnp.float32))
    y = jnp.concatenate([o_a.reshape(n, t, WIDTH_A), y_b.astype(o_a.dtype)], axis=-1)
    return y @ w_o


def mem_kv(mem, g_mem, w_mk, w_mv):
    n = mem.shape[0]
    m = rmsnorm(mem, g_mem)
    k = (m @ w_mk).reshape(n, N_MEM, N_HEADS_MEM, HEAD_DIM_MEM)
    v = (m @ w_mv).reshape(n, N_MEM, N_HEADS_MEM, HEAD_DIM_MEM)
    return k, v


def mem_attention(h, k, v, w_mq, w_mo):
    n, t = h.shape[:2]
    q = (h @ w_mq).reshape(n, t, N_HEADS_MEM, HEAD_DIM_MEM)
    s = jnp.einsum('nqhd,nkhd->nhqk', q, k.astype(q.dtype)).astype(jnp.float32) * (HEAD_DIM_MEM ** -0.5)
    p = jax.nn.softmax(s, axis=-1).astype(q.dtype)
    o = jnp.einsum('nhqk,nkhd->nqhd', p, v.astype(q.dtype)).reshape(n, t, D_MODEL)
    return o @ w_mo


def swiglu(h, w_gate, w_up, w_down):
    return (jax.nn.silu(h @ w_gate) * (h @ w_up)) @ w_down


def setup_inputs(seed: int = 0) -> dict:
    key = jax.random.key(seed)
    ks = iter(jax.random.split(key, 40))
    nrm = lambda shape, scale: jax.random.normal(next(ks), shape, jnp.float32) * scale
    gain = lambda shape: 1.0 + nrm(shape, 0.05)
    a_keep = min(A_WINDOW, PAST_LEN)
    L = DEPTH
    return {
        "x_prompt": nrm((BATCH, SEQ, D_MODEL), 1.0),
        "x_sample": nrm((DEC_BATCH, DEC_SEQ, D_MODEL), 1.0),
        "mem_prompt": nrm((BATCH, N_MEM, D_MODEL), 1.0),
        "cache_a_k": nrm((L, DEC_BATCH, a_keep, N_HEADS_A, HEAD_DIM_A), 1.0),
        "cache_a_v": nrm((L, DEC_BATCH, a_keep, N_HEADS_A, HEAD_DIM_A), 1.0),
        "state_gla": nrm((L, DEC_BATCH, N_HEADS_B, KEY_DIM_B, VAL_DIM_B), 1.0),
        "cache_mem_k": nrm((L, DEC_BATCH, N_MEM, N_HEADS_MEM, HEAD_DIM_MEM), 1.0),
        "cache_mem_v": nrm((L, DEC_BATCH, N_MEM, N_HEADS_MEM, HEAD_DIM_MEM), 1.0),
        "g_pre_mix": gain((L, D_MODEL)),
        "w_in": nrm((L, D_MODEL, IN_WIDTH), D_MODEL ** -0.5),
        "rel_bias": nrm((L, N_HEADS_A, 2 * REL_CLIP + 1), 0.2),
        "w_alpha2": nrm((L, GATE_RANK, WIDTH_BK), GATE_RANK ** -0.5),
        "b_alpha": nrm((L, WIDTH_BK), 0.1),
        "g_gla_out": gain((L, WIDTH_BV)),
        "w_o": nrm((L, MIX_WIDTH, D_MODEL), MIX_WIDTH ** -0.5),
        "g_post_mix": gain((L, D_MODEL)),
        "g_pre_mem": gain((L, D_MODEL)),
        "g_mem": gain((L, D_MODEL)),
        "w_mq": nrm((L, D_MODEL, D_MODEL), D_MODEL ** -0.5),
        "w_mk": nrm((L, D_MODEL, D_MODEL), D_MODEL ** -0.5),
        "w_mv": nrm((L, D_MODEL, D_MODEL), D_MODEL ** -0.5),
        "w_mo": nrm((L, D_MODEL, D_MODEL), D_MODEL ** -0.5),
        "g_post_mem": gain((L, D_MODEL)),
        "g_pre_ffn": gain((L, D_MODEL)),
        "w_ffn_gate": nrm((L, D_MODEL, D_FF), D_MODEL ** -0.5),
        "w_ffn_up": nrm((L, D_MODEL, D_FF), D_MODEL ** -0.5),
        "w_ffn_down": nrm((L, D_FF, D_MODEL), D_FF ** -0.5),
        "g_post_ffn": gain((L, D_MODEL)),
    }


def reference(x_prompt, x_sample, mem_prompt, cache_a_k, cache_a_v, state_gla, cache_mem_k, cache_mem_v,
              g_pre_mix, w_in, rel_bias, w_alpha2, b_alpha, g_gla_out, w_o, g_post_mix,
              g_pre_mem, g_mem, w_mq, w_mk, w_mv, w_mo, g_post_mem,
              g_pre_ffn, w_ffn_gate, w_ffn_up, w_ffn_down, g_post_ffn):
    xp, xs = x_prompt, x_sample
    pa_k, pa_v, p_gla, p_mk, p_mv, sa_k, sa_v, s_gla = [], [], [], [], [], [], [], []
    for l in range(DEPTH):
        hp = rmsnorm(xp, g_pre_mix[l])
        qa, ka, va, qb, kb, vb, la, r = mix_inputs(hp, w_in[l], w_alpha2[l], b_alpha[l])
        oa = chunk_band_prompt(qa, ka, va, rel_bias[l])
        s0 = jnp.zeros((xp.shape[0], N_HEADS_B, KEY_DIM_B, VAL_DIM_B), jnp.float32)
        ob, sp = gla_recurrence(qb, kb, vb, la, s0, GLA_BLOCK)
        xp = xp + rmsnorm(mix_output(oa, ob, r, g_gla_out[l], w_o[l]), g_post_mix[l])
        keep = min(A_WINDOW, ka.shape[1])
        pa_k.append(ka[:, -keep:])
        pa_v.append(va[:, -keep:])
        p_gla.append(sp)

        hs = rmsnorm(xs, g_pre_mix[l])
        qa_s, ka_s, va_s, qb_s, kb_s, vb_s, la_s, r_s = mix_inputs(hs, w_in[l], w_alpha2[l], b_alpha[l])
        oa_s = chunk_band_sample(qa_s, ka_s, va_s, cache_a_k[l], cache_a_v[l], rel_bias[l])
        ob_s, ss = gla_recurrence(qb_s, kb_s, vb_s, la_s, state_gla[l], xs.shape[1])
        xs = xs + rmsnorm(mix_output(oa_s, ob_s, r_s, g_gla_out[l], w_o[l]), g_post_mix[l])
        sa_k.append(ka_s)
        sa_v.append(va_s)
        s_gla.append(ss)

        mk, mv = mem_kv(mem_prompt, g_mem[l], w_mk[l], w_mv[l])
        xp = xp + rmsnorm(mem_attention(rmsnorm(xp, g_pre_mem[l]), mk, mv, w_mq[l], w_mo[l]), g_post_mem[l])
        xs = xs + rmsnorm(mem_attention(rmsnorm(xs, g_pre_mem[l]), cache_mem_k[l], cache_mem_v[l], w_mq[l], w_mo[l]), g_post_mem[l])
        p_mk.append(mk)
        p_mv.append(mv)

        xp = xp + rmsnorm(swiglu(rmsnorm(xp, g_pre_ffn[l]), w_ffn_gate[l], w_ffn_up[l], w_ffn_down[l]), g_post_ffn[l])
        xs = xs + rmsnorm(swiglu(rmsnorm(xs, g_pre_ffn[l]), w_ffn_gate[l], w_ffn_up[l], w_ffn_down[l]), g_post_ffn[l])

    return (xp, xs, jnp.stack(pa_k), jnp.stack(pa_v), jnp.stack(p_gla), jnp.stack(p_mk), jnp.stack(p_mv),
            jnp.stack(sa_k), jnp.stack(sa_v), jnp.stack(s_gla))
```

```cpp
#include <hip/hip_runtime.h>
#include <hip/hip_cooperative_groups.h>
#include <cstdio>
#include <cstdint>
namespace cg = cooperative_groups;
namespace pg8 {
#define PG8_LAS __attribute__((address_space(3)))
typedef unsigned short bf16_t;
typedef short bf16x8 __attribute__((ext_vector_type(8)));
typedef float f32x4 __attribute__((ext_vector_type(4)));
typedef unsigned u32x4 __attribute__((ext_vector_type(4)));
constexpr int BM = 256, BK = 64, HALF = 128, HTB = HALF * BK * 2  , STAGE_BYTES = 8 * HTB, NXCD = 8, WGM = 8;

__host__ __device__ __forceinline__ int lds_byte(int r, int c) { const int st = (r >> 4) * 2 + (c >> 5), rr = r & 15, cc = c & 31, ob = rr * 64 + cc * 2; return st * 1024 + (ob ^ (((ob >> 9) & 1) << 5)); }
__host__ __device__ __forceinline__ void stage_rc(int b, int& R, int& C) { const int st = b / 1024, sb = b % 1024, swz = sb ^ (((sb >> 9) & 1) << 5); R = (st >> 1) * 16 + swz / 64; C = (st & 1) * 32 + (swz % 64) / 2; }
__host__ __device__ __forceinline__ int perm32(int rho) { const int n = rho >> 4, i = rho & 15; return 8 * (i >> 2) + 4 * n + (i & 3); }

struct Unit { int pm, pn; };
struct Gemm { const bf16_t* A; const bf16_t* Bt; int M, N, K; };

struct StaticOrder {
    int nM, nN, nwg, G, c;
    __host__ __device__ void init(int M, int N, int G_, int c_) { nM = M / BM; nN = N / BM; nwg = nM * nN; G = G_; c = c_; }
    __host__ __device__ bool next(int i, Unit& u) const {
        const long L = (long)i * G + c; if (L >= nwg) return false;
        int wgid = (int)L; { const int q = nwg / NXCD, r = nwg % NXCD, xcd = wgid % NXCD, off = wgid / NXCD; wgid = (xcd < r ? xcd * (q + 1) : r * (q + 1) + (xcd - r) * q) + off; }
        const int nig = WGM * nN, gid = wgid / nig, fm = gid * WGM, gsz = (nM - fm) < WGM ? (nM - fm) : WGM;
        u.pm = fm + ((wgid % nig) % gsz); u.pn = (wgid % nig) / gsz; return true;
    }
    __device__ __forceinline__ void a_ready(const Unit&) const {}
    __device__ __forceinline__ void done(const Unit&) const {}
};

__device__ __forceinline__ unsigned cvt_pk_bf16(float lo, float hi) { unsigned r; asm volatile("v_cvt_pk_bf16_f32 %0, %1, %2" : "=v"(r) : "v"(lo), "v"(hi)); return r; }
template <class Epi, class Sched, bool ALIGN_EPI = false, bool SP2 = false>
__device__ __forceinline__ void gemm_phase(PG8_LAS unsigned char* lds, const Gemm g, const Sched& S, const Epi& E) {
    int tid_ = threadIdx.x; asm volatile("" : "+v"(tid_));
    const int tid = tid_, wid = __builtin_amdgcn_readfirstlane(tid >> 6), lane = tid & 63, wr = wid >> 2, wc = wid & 3, fr = lane & 15, fq = lane >> 4;
    const int K = g.K, nt = K / BK;
    unsigned voffA[2], voffB[2];
#pragma unroll
    for (int i = 0; i < 2; ++i) { int R, C; stage_rc(tid * 16 + i * 8192, R, C); const int Rb = Epi::PERM ? ((R & ~31) + perm32(R & 31)) : R;
        voffA[i] = (unsigned)(R * K + C) * 2u; voffB[i] = (unsigned)(Rb * K + C) * 2u; }
    const size_t kstep = (size_t)(BK * 2);
    const size_t hstep = (size_t)HALF * K * 2;
    const size_t tstep = 2 * hstep;
    const unsigned ldsw = (unsigned)wid * 1024u;
    const int aoff = lds_byte(wr * 64 + fr, fq * 8), boff = lds_byte(wc * 32 + fr, fq * 8);
#define PG8_SA(b, h) (((b) * 2 + (h)) * HTB)
#define PG8_SB(b, h) ((4 + (b) * 2 + (h)) * HTB)
#define PG8_STAGE(bufoff, gbase, voff) do { _Pragma("unroll") for (int _i = 0; _i < 2; ++_i) \
        __builtin_amdgcn_global_load_lds((const unsigned*)((const char*)(gbase) + (voff)[_i]), (PG8_LAS unsigned*)(lds + (bufoff) + ldsw + _i * 8192), 16, 0, 0); } while (0)
#define PG8_LDA(dst, b, h) do { _Pragma("unroll") for (int m = 0; m < 4; ++m) _Pragma("unroll") for (int k = 0; k < 2; ++k) dst[m][k] = *(const PG8_LAS bf16x8*)(lds + PG8_SA(b, h) + aoff + m * 2048 + k * 1024); } while (0)
#define PG8_LDB(dst, b, h) do { _Pragma("unroll") for (int n = 0; n < 2; ++n) _Pragma("unroll") for (int k = 0; k < 2; ++k) dst[n][k] = *(const PG8_LAS bf16x8*)(lds + PG8_SB(b, h) + boff + n * 2048 + k * 1024); } while (0)
#define PG8_MMA(ai, bj, At, Bt) do { __builtin_amdgcn_s_setprio(1); _Pragma("unroll") for (int m = 0; m < 4; ++m) _Pragma("unroll") for (int n = 0; n < 2; ++n) _Pragma("unroll") for (int k = 0; k < 2; ++k) \
        acc[ai][bj][m][n] = __builtin_amdgcn_mfma_f32_16x16x32_bf16(Bt[n][k], At[m][k], acc[ai][bj][m][n], 0, 0, 0); __builtin_amdgcn_s_setprio(0); } while (0)
#define PG8_WAIT_V(n) asm volatile("s_waitcnt vmcnt(" #n ")" ::: "memory")
#define PG8_WAIT_L(n) asm volatile("s_waitcnt lgkmcnt(" #n ")" ::: "memory")
#define PG8_BAR __builtin_amdgcn_s_barrier()
#define PG8_SCHED __builtin_amdgcn_sched_barrier(0)
    Unit cur, nxt; int ui = 0;
    if (!S.next(0, cur)) return;
    f32x4 acc[2][2][4][2];
#pragma unroll
    for (int a = 0; a < 2; ++a)
#pragma unroll
        for (int b = 0; b < 2; ++b)
#pragma unroll
            for (int m = 0; m < 4; ++m)
#pragma unroll
                for (int n = 0; n < 2; ++n) acc[a][b][m][n] = (f32x4){0.f, 0.f, 0.f, 0.f};
    bf16x8 At[4][2], B0[2][2], B1[2][2];
    const char* cA = (const char*)g.A + (size_t)cur.pm * tstep; const char* cB = (const char*)g.Bt + (size_t)cur.pn * tstep;
    S.a_ready(cur);
    if constexpr (SP2) {
        PG8_STAGE(PG8_SB(0, 0), cB, voffB); PG8_STAGE(PG8_SB(0, 1), cB + hstep, voffB); PG8_STAGE(PG8_SA(0, 0), cA, voffA); PG8_STAGE(PG8_SA(0, 1), cA + hstep, voffA);
        if (wr == 1) PG8_BAR;
        PG8_WAIT_V(2); PG8_BAR;
        PG8_STAGE(PG8_SB(1, 0), cB + kstep, voffB); PG8_STAGE(PG8_SA(1, 0), cA + kstep, voffA); PG8_STAGE(PG8_SB(1, 1), cB + hstep + kstep, voffB);
        PG8_WAIT_V(6); PG8_BAR;
    } else {
        PG8_STAGE(PG8_SB(0, 0), cB, voffB); PG8_STAGE(PG8_SA(0, 0), cA, voffA); PG8_STAGE(PG8_SB(0, 1), cB + hstep, voffB); PG8_STAGE(PG8_SA(0, 1), cA + hstep, voffA);
        if (wr == 1) PG8_BAR;
        PG8_WAIT_V(4); PG8_BAR;
        PG8_STAGE(PG8_SB(1, 0), cB + kstep, voffB); PG8_STAGE(PG8_SA(1, 0), cA + kstep, voffA); PG8_STAGE(PG8_SB(1, 1), cB + hstep + kstep, voffB);
        PG8_WAIT_V(6); PG8_BAR;
    }
    for (;;) {
        const bool has_next = S.next(ui + 1, nxt);
        const char* nA = has_next ? (const char*)g.A + (size_t)nxt.pm * tstep : cA; const char* nB = has_next ? (const char*)g.Bt + (size_t)nxt.pn * tstep : cB;
        for (int t = 0; t < nt; t += 2) {
            const bool last = (t == nt - 2);
            const char* a1 = cA + (size_t)(t + 1) * kstep;
            const char* a2 = last ? nA : cA + (size_t)(t + 2) * kstep; const char* b2 = last ? nB : cB + (size_t)(t + 2) * kstep;
            const char* a3 = a2 + kstep; const char* b3 = b2 + kstep;
            if (last && has_next) S.a_ready(nxt);
            if constexpr (SP2) {
            PG8_LDB(B0, 0, 0); PG8_LDB(B1, 0, 1); PG8_SCHED; PG8_LDA(At, 0, 0); PG8_STAGE(PG8_SA(1, 1), a1 + hstep, voffA);
            PG8_WAIT_V(8); PG8_WAIT_L(0); PG8_BAR; PG8_MMA(0, 0, At, B0); PG8_MMA(0, 1, At, B1); PG8_BAR; PG8_SCHED;
            PG8_LDA(At, 0, 1); PG8_STAGE(PG8_SB(0, 0), b2, voffB); PG8_STAGE(PG8_SB(0, 1), b2 + hstep, voffB); PG8_STAGE(PG8_SA(0, 0), a2, voffA);
            PG8_WAIT_V(8); PG8_WAIT_L(0); PG8_BAR; PG8_MMA(1, 0, At, B0); PG8_MMA(1, 1, At, B1); PG8_BAR; PG8_SCHED;
            PG8_LDB(B0, 1, 0); PG8_LDB(B1, 1, 1); PG8_SCHED; PG8_LDA(At, 1, 0); PG8_STAGE(PG8_SA(0, 1), a2 + hstep, voffA);
            PG8_WAIT_V(8); PG8_WAIT_L(0); PG8_BAR; PG8_MMA(0, 0, At, B0); PG8_MMA(0, 1, At, B1); PG8_BAR; PG8_SCHED;
            PG8_LDA(At, 1, 1); PG8_STAGE(PG8_SB(1, 0), b3, voffB); PG8_STAGE(PG8_SB(1, 1), b3 + hstep, voffB); PG8_STAGE(PG8_SA(1, 0), a3, voffA);
            PG8_WAIT_V(8); PG8_WAIT_L(0); PG8_BAR; PG8_MMA(1, 0, At, B0); PG8_MMA(1, 1, At, B1); PG8_BAR; PG8_SCHED;
            } else {
            PG8_LDB(B0, 0, 0); PG8_SCHED; PG8_LDA(At, 0, 0); PG8_STAGE(PG8_SA(1, 1), a1 + hstep, voffA);
            PG8_WAIT_L(8); PG8_BAR; PG8_WAIT_L(0); PG8_MMA(0, 0, At, B0); PG8_BAR; PG8_SCHED;
            PG8_LDB(B1, 0, 1); PG8_STAGE(PG8_SB(0, 0), b2, voffB);
            PG8_BAR; PG8_WAIT_L(0); PG8_MMA(0, 1, At, B1); PG8_BAR;
            PG8_LDA(At, 0, 1); PG8_STAGE(PG8_SA(0, 0), a2, voffA);
            PG8_BAR; PG8_WAIT_L(0); PG8_MMA(1, 0, At, B0); PG8_BAR; PG8_SCHED;
            PG8_STAGE(PG8_SB(0, 1), b2 + hstep, voffB);
            PG8_WAIT_V(6); PG8_BAR; PG8_MMA(1, 1, At, B1); PG8_BAR;
            PG8_LDB(B0, 1, 0); PG8_SCHED; PG8_LDA(At, 1, 0); PG8_STAGE(PG8_SA(0, 1), a2 + hstep, voffA);
            PG8_WAIT_L(8); PG8_BAR; PG8_WAIT_L(0); PG8_MMA(0, 0, At, B0); PG8_BAR; PG8_SCHED;
            PG8_LDB(B1, 1, 1); PG8_STAGE(PG8_SB(1, 0), b3, voffB);
            PG8_BAR; PG8_WAIT_L(0); PG8_MMA(0, 1, At, B1); PG8_BAR;
            PG8_LDA(At, 1, 1); PG8_STAGE(PG8_SA(1, 0), a3, voffA);
            PG8_BAR; PG8_WAIT_L(0); PG8_MMA(1, 0, At, B0); PG8_BAR; PG8_SCHED;
            PG8_STAGE(PG8_SB(1, 1), b3 + hstep, voffB);
            PG8_WAIT_V(6); PG8_BAR; PG8_MMA(1, 1, At, B1); PG8_BAR;
            }
        }
        if constexpr (ALIGN_EPI) { if (wr == 0) PG8_BAR; }
        if constexpr (!Epi::AFTER_DRAIN) { E(acc, cur, wr, wc, fr, fq); S.done(cur); }
        if (!has_next) break;
#pragma unroll
        for (int a = 0; a < 2; ++a)
#pragma unroll
            for (int b = 0; b < 2; ++b)
#pragma unroll
                for (int m = 0; m < 4; ++m)
#pragma unroll
                    for (int n = 0; n < 2; ++n) acc[a][b][m][n] = (f32x4){0.f, 0.f, 0.f, 0.f};
        cur = nxt; cA = nA; cB = nB; ++ui;
        if constexpr (ALIGN_EPI) { if (wr == 1) PG8_BAR; }
    }
    PG8_WAIT_V(0);
    if constexpr (!ALIGN_EPI) { if (wr == 0) PG8_BAR; }
    PG8_BAR;
    if constexpr (Epi::AFTER_DRAIN) { E.fused(acc, cur, wr, wc, fr, fq, lds, wid, lane); S.done(cur); }
#undef PG8_SA
#undef PG8_SB
#undef PG8_STAGE
#undef PG8_LDA
#undef PG8_LDB
#undef PG8_MMA
#undef PG8_WAIT_V
#undef PG8_WAIT_L
#undef PG8_BAR
#undef PG8_SCHED
}
}
using pg8::bf16_t; using pg8::bf16x8; using pg8::f32x4; using pg8::u32x4;
#define LAS __attribute__((address_space(3)))
typedef float f32x16 __attribute__((ext_vector_type(16)));
typedef float f32x2_t __attribute__((ext_vector_type(2)));
typedef __bf16 bf16x2_t __attribute__((ext_vector_type(2)));
typedef unsigned u32x2 __attribute__((ext_vector_type(2)));
typedef short s16x4 __attribute__((ext_vector_type(4)));
#define MFMA32(a, b, c) __builtin_amdgcn_mfma_f32_32x32x16_bf16((a), (b), (c), 0, 0, 0)

constexpr int DM = 1024, SEQ = 16384, NBP = 2, MP = NBP * SEQ, NBS = 16, TS = 32, MS = NBS * TS, MT = MP + MS;
constexpr int NIN = 3328, DFF = 2816, NCH = SEQ / 64;
constexpr float EPS = 1e-6f, LOG2E = 1.4426950408889634f;
constexpr int NTHREADS = 512, NWAVES = 8;
constexpr int LDS_BYTES = 155648;
constexpr int EPT_OFF = 131072, EPT_WAVE = 2560;

constexpr size_t OUT_Y = 0, OUT_PAK = 34078720, OUT_PAV = 34603008, OUT_PGLA = 35127296, OUT_PMK = 35192832, OUT_PMV = 35717120,
                 OUT_SAK = 36241408, OUT_SAV = 36503552, OUT_SGLA = 36765696, OUT_TOTAL = 37289984;
constexpr size_t KiB = 1024, MiB = 1024 * 1024;
constexpr size_t WS_WIN = 1 * MiB, WS_WO = 8 * MiB, WS_WMQ = 10 * MiB, WS_WMKV = 12 * MiB, WS_WMO = 16 * MiB, WS_WGU = 18 * MiB, WS_WD = 29 * MiB;
constexpr size_t WS_MN = 35 * MiB, WS_KMP = 36 * MiB, WS_VMTP = 37 * MiB, WS_KMS = 38 * MiB, WS_VMTS = 46 * MiB;
constexpr size_t WS_H = 54 * MiB, WS_Y = 119 * MiB, WS_U = 184 * MiB, WS_DS = WS_U, WS_DEC = 248 * MiB;
constexpr size_t WS_R = 249 * MiB;
constexpr size_t WS_QA = WS_R, WS_KP = WS_QA + 33280 * KiB, WS_VPT = WS_KP + 32 * MiB, WS_KS = WS_VPT + 32 * MiB, WS_VST = WS_KS + 8704 * KiB,
                 WS_QB = WS_VST + 8704 * KiB, WS_KB = WS_QB + 16640 * KiB, WS_VB = WS_KB + 16640 * KiB, WS_RS = WS_VB + 33280 * KiB, WS_LA = WS_RS + 33280 * KiB,
                 WS_END = WS_LA + 33280 * KiB;
constexpr size_t WS_HID = WS_R;
constexpr size_t WS_VBS = WS_VB + 32 * MiB, WS_LAS = WS_LA + 32 * MiB;
constexpr size_t WS_BT1 = WS_END, WS_BT2 = WS_END + 4 * MiB, WS_WMQN = WS_END + 16 * MiB, WS_VMN = WS_WMQN + 2 * MiB;
static_assert(WS_VMN + 1 * MiB <= 512 * MiB, "ws map 3");
constexpr size_t WS_KBT = WS_END, WS_BC = WS_H, WS_SST = WS_H + 32 * MiB;
static_assert(WS_KBT + 16 * MiB <= 512 * MiB && WS_SST + 32 * MiB <= WS_Y, "ws map 2");
static_assert(WS_HID + (size_t)MT * DFF * 2 <= WS_END && WS_END <= 512 * MiB, "ws map");

struct Params { const float* in[28]; float* out; unsigned char* ws; };
enum { I_XP = 0, I_XS, I_MEM, I_CAK, I_CAV, I_SGLA, I_CMK, I_CMV, I_GPREMIX, I_WIN, I_RELB, I_WA2, I_BA, I_GGLA, I_WO, I_GPOSTMIX, I_GPREMEM, I_GMEM,
       I_WMQ, I_WMK, I_WMV, I_WMO, I_GPOSTMEM, I_GPREFFN, I_WG, I_WU, I_WDN, I_GPOSTFFN };

__device__ __forceinline__ unsigned pk2(float lo, float hi) { f32x2_t v = {lo, hi}; bf16x2_t b = __builtin_convertvector(v, bf16x2_t); return __builtin_bit_cast(unsigned, b); }
__device__ __forceinline__ bf16_t f2bf(float f) { return (bf16_t)(pk2(f, 0.f) & 0xffffu); }
__device__ __forceinline__ float bf2f(unsigned b) { return __uint_as_float(b << 16); }
__device__ __forceinline__ int crow(int i, int h) { return (i & 3) + 8 * (i >> 2) + 4 * h; }
__device__ __forceinline__ float wave_sum(float v) {
#pragma unroll
    for (int o = 1; o < 64; o <<= 1) v += __shfl_xor(v, o);
    return v;
}
__device__ __forceinline__ float silu_f(float x) { return x / (1.f + __expf(-x)); }
__device__ __forceinline__ float logsig(float z) { return fminf(z, 0.f) - __logf(1.f + __expf(-fabsf(z))); }
__device__ __forceinline__ bf16x8 pack8(float x0, float x1, float x2, float x3, float x4, float x5, float x6, float x7) {
    u32x4 w; w.x = pk2(x0, x1); w.y = pk2(x2, x3); w.z = pk2(x4, x5); w.w = pk2(x6, x7); return __builtin_bit_cast(bf16x8, w);
}
#define LDS_WAIT() asm volatile("s_waitcnt lgkmcnt(0)" ::: "memory")

#define EPI_LOOP_BEGIN \
    _Pragma("unroll") for (int ai = 0; ai < 2; ++ai) _Pragma("unroll") for (int m = 0; m < 4; ++m) { \
        const int row = u.pm * 256 + ai * 128 + wr * 64 + m * 16 + fr; \
        _Pragma("unroll") for (int bj = 0; bj < 2; ++bj) _Pragma("unroll") for (int n = 0; n < 2; ++n) { \
            const int c = bj * 128 + wc * 32 + n * 16 + fq * 4; const f32x4 v = acc[ai][bj][m][n];
#define EPI_LOOP_END } asm volatile("" ::: "memory"); }

__device__ __forceinline__ void st_bf4(bf16_t* p, f32x4 v) { u32x2 w; w.x = pk2(v[0], v[1]); w.y = pk2(v[2], v[3]); *(u32x2*)p = w; }
__device__ __forceinline__ void st_bf8(bf16_t* p, f32x4 a, f32x4 b) { u32x4 w; w.x = pk2(a[0], a[1]); w.y = pk2(a[2], a[3]); w.z = pk2(b[0], b[1]); w.w = pk2(b[2], b[3]); *(u32x4*)p = w; }


__device__ __forceinline__ void tr_store_bf16(const f32x4 (&acc)[2][2][4][2], LAS unsigned char* tl, bf16_t* dst  , int wr, int wc, int fr, int fq, int lane) {
#pragma unroll
    for (int ai = 0; ai < 2; ++ai)
#pragma unroll
        for (int bj = 0; bj < 2; ++bj)
#pragma unroll
            for (int mh = 0; mh < 2; ++mh) {
#pragma unroll
                for (int mm = 0; mm < 2; ++mm)
#pragma unroll
                    for (int n = 0; n < 2; ++n) { const f32x4 v = acc[ai][bj][2 * mh + mm][n];
#pragma unroll
                        for (int e = 0; e < 4; ++e) *(LAS bf16_t*)(tl + (8 * fq + 4 * n + e) * 80 + (16 * mm + fr) * 2) = f2bf(v[e]); }
#pragma unroll
                for (int k = 0; k < 2; ++k) { const int p = lane + 64 * k, col = p >> 2, pc = p & 3;
                    const u32x4 w = *(const LAS u32x4*)(tl + col * 80 + pc * 16);
                    *(u32x4*)(dst + (size_t)(128 * bj + 32 * wc + col) * SEQ + 128 * ai + 64 * wr + 32 * mh + 8 * pc) = w; }
            }
}
__device__ __forceinline__ void tr_store_la(const f32x4 (&vals)[2][2][4][2], LAS unsigned char* tl, float* dst, const float* b_alpha, int wr, int wc, int fr, int fq, int lane) {
#pragma unroll
    for (int ai = 0; ai < 2; ++ai)
#pragma unroll
        for (int bj = 0; bj < 2; ++bj)
#pragma unroll
            for (int m = 0; m < 4; ++m) {
#pragma unroll
                for (int n = 0; n < 2; ++n) { const f32x4 v = vals[ai][bj][m][n]; const f32x4 bb = *(const f32x4*)(b_alpha + 128 * bj + 32 * wc + 8 * fq + 4 * n);
#pragma unroll
                    for (int e = 0; e < 4; ++e) *(LAS float*)(tl + (8 * fq + 4 * n + e) * 80 + fr * 4) = logsig(v[e] + bb[e]) * 0.0625f; }
#pragma unroll
                for (int k = 0; k < 2; ++k) { const int p = lane + 64 * k, col = p >> 2, pc = p & 3;
                    const f32x4 w = *(const LAS f32x4*)(tl + col * 80 + pc * 16);
                    *(f32x4*)(dst + (size_t)(128 * bj + 32 * wc + col) * SEQ + 128 * ai + 64 * wr + 16 * m + 4 * pc) = w; }
            }
}

struct EpiIn {
    static constexpr bool PERM = true, AFTER_DRAIN = false;
    unsigned char* wsb; const float* b_alpha; float* outb; LAS unsigned char* ept;
    template <int KIND> __device__ __forceinline__ void run(const f32x4 (&acc)[2][2][4][2], const pg8::Unit& u, int wr, int wc, int fr, int fq) const {
        const int pn = u.pn; const bool isP = u.pm < MP / 256;
        __attribute__((address_space(1))) unsigned char* wg_ = (__attribute__((address_space(1))) unsigned char*)wsb; asm volatile("" : "+s"(wg_)); unsigned char* ws = (unsigned char*)wg_;
        __attribute__((address_space(1))) float* og_ = (__attribute__((address_space(1))) float*)outb; asm volatile("" : "+s"(og_)); float* out = (float*)og_;
        bf16_t* QA = (bf16_t*)(ws + WS_QA); bf16_t* KP = (bf16_t*)(ws + WS_KP); bf16_t* VPT = (bf16_t*)(ws + WS_VPT); bf16_t* KS = (bf16_t*)(ws + WS_KS); bf16_t* VST = (bf16_t*)(ws + WS_VST);
        bf16_t* QB = (bf16_t*)(ws + WS_QB); bf16_t* KB = (bf16_t*)(ws + WS_KB); bf16_t* VB = (bf16_t*)(ws + WS_VB); bf16_t* RS = (bf16_t*)(ws + WS_RS); float* LA = (float*)(ws + WS_LA);
        bf16_t* KBT = (bf16_t*)(ws + WS_KBT); bf16_t* VBS = (bf16_t*)(ws + WS_VBS); float* LAS_ = (float*)(ws + WS_LAS);
        (void)QA; (void)KP; (void)VPT; (void)KS; (void)VST; (void)QB; (void)KB; (void)VB; (void)RS; (void)LA; (void)KBT; (void)VBS; (void)LAS_; (void)out;
#pragma unroll
        for (int ai = 0; ai < 2; ++ai)
#pragma unroll
            for (int m = 0; m < 4; ++m) {
                const int row = u.pm * 256 + ai * 128 + wr * 64 + m * 16 + fr; const int rs = row - MP;
                const int pb = row >> 14, pt = row & (SEQ - 1), sb = rs >> 5, st = rs & 31;
#pragma unroll
                for (int bj = 0; bj < 2; ++bj) {
                    const int c = bj * 128 + wc * 32 + 8 * fq;
                    const f32x4 v0 = acc[ai][bj][m][0], v1 = acc[ai][bj][m][1];
                    if constexpr (KIND == 0) {
                        st_bf8(QA + (size_t)row * 512 + pn * 256 + c, v0 * (0.125f * LOG2E), v1 * (0.125f * LOG2E));
                    } else if constexpr (KIND == 1) {
                        const int col = (pn - 2) * 256 + c;
                        if (isP) { st_bf8(KP + (size_t)row * 512 + col, v0, v1);
                                   if (pt >= SEQ - 512) { float* o = out + OUT_PAK + ((size_t)pb * 512 + (pt - (SEQ - 512))) * 512 + col; *(f32x4*)o = v0; *(f32x4*)(o + 4) = v1; } }
                        else     { st_bf8(KS + ((size_t)sb * 544 + 512 + st) * 512 + col, v0, v1);
                                   float* o = out + OUT_SAK + (size_t)rs * 512 + col; *(f32x4*)o = v0; *(f32x4*)(o + 4) = v1; }
                    } else if constexpr (KIND == 2) {
                        const int col = (pn - 4) * 256 + c;
                        if (isP) { if (pt >= SEQ - 512) { float* o = out + OUT_PAV + ((size_t)pb * 512 + (pt - (SEQ - 512))) * 512 + col; *(f32x4*)o = v0; *(f32x4*)(o + 4) = v1; } }
                        else     { bf16_t* p = VST + ((size_t)sb * 512 + col) * 544 + 512 + st;
                                   p[0] = f2bf(v0[0]); p[544] = f2bf(v0[1]); p[2 * 544] = f2bf(v0[2]); p[3 * 544] = f2bf(v0[3]);
                                   p[4 * 544] = f2bf(v1[0]); p[5 * 544] = f2bf(v1[1]); p[6 * 544] = f2bf(v1[2]); p[7 * 544] = f2bf(v1[3]);
                                   float* o = out + OUT_SAV + (size_t)rs * 512 + col; *(f32x4*)o = v0; *(f32x4*)(o + 4) = v1; }
                    } else if constexpr (KIND == 3) {
                        st_bf8(QB + (size_t)row * 256 + c, v0 * 0.125f, v1 * 0.125f);
                    } else if constexpr (KIND == 4) {
                        st_bf8(KB + (size_t)row * 256 + c, v0, v1);
                    } else if constexpr (KIND == 5) {
                        if (!isP) st_bf8(VBS + (size_t)rs * 512 + (pn - 8) * 256 + c, v0, v1);
                    } else if constexpr (KIND == 6) {
                        f32x4 s0, s1; s0[0] = silu_f(v0[0]); s0[1] = silu_f(v0[1]); s0[2] = silu_f(v0[2]); s0[3] = silu_f(v0[3]);
                        s1[0] = silu_f(v1[0]); s1[1] = silu_f(v1[1]); s1[2] = silu_f(v1[2]); s1[3] = silu_f(v1[3]);
                        st_bf8(RS + (size_t)row * 512 + (pn - 10) * 256 + c, s0, s1);
                    } else {
                        if (!isP) { const f32x4 b0 = *(const f32x4*)(b_alpha + c), b1 = *(const f32x4*)(b_alpha + c + 4); f32x4 s0, s1;
                            s0[0] = logsig(v0[0] + b0[0]) * 0.0625f; s0[1] = logsig(v0[1] + b0[1]) * 0.0625f; s0[2] = logsig(v0[2] + b0[2]) * 0.0625f; s0[3] = logsig(v0[3] + b0[3]) * 0.0625f;
                            s1[0] = logsig(v1[0] + b1[0]) * 0.0625f; s1[1] = logsig(v1[1] + b1[1]) * 0.0625f; s1[2] = logsig(v1[2] + b1[2]) * 0.0625f; s1[3] = logsig(v1[3] + b1[3]) * 0.0625f;
                            float* o = LAS_ + (size_t)rs * 256 + c; *(f32x4*)o = s0; *(f32x4*)(o + 4) = s1; }
                    }
                }
                asm volatile("" ::: "memory");
            }
        if (isP) {
            const int lane = threadIdx.x & 63; const int pb0 = (u.pm * 256) >> 14, pt0 = (u.pm * 256) & (SEQ - 1); LAS unsigned char* tl = ept + (threadIdx.x >> 6) * EPT_WAVE;
            if constexpr (KIND == 2) tr_store_bf16(acc, tl, VPT + ((size_t)pb0 * 512 + (pn - 4) * 256) * SEQ + pt0, wr, wc, fr, fq, lane);
            if constexpr (KIND == 4) tr_store_bf16(acc, tl, KBT + ((size_t)pb0 * 256) * SEQ + pt0, wr, wc, fr, fq, lane);
            if constexpr (KIND == 5) tr_store_bf16(acc, tl, VB + ((size_t)pb0 * 512 + (pn - 8) * 256) * SEQ + pt0, wr, wc, fr, fq, lane);
            if constexpr (KIND == 7) tr_store_la(acc, tl, LA + ((size_t)pb0 * 256) * SEQ + pt0, b_alpha, wr, wc, fr, fq, lane);
        }
    }
    __device__ __forceinline__ void operator()(const f32x4 (&acc)[2][2][4][2], const pg8::Unit& u, int wr, int wc, int fr, int fq) const {
        asm volatile("" : "+v"(fr), "+v"(fq));
        const int pn = u.pn;
        if (pn < 2) run<0>(acc, u, wr, wc, fr, fq);
        else if (pn < 4) run<1>(acc, u, wr, wc, fr, fq);
        else if (pn < 6) run<2>(acc, u, wr, wc, fr, fq);
        else if (pn == 6) run<3>(acc, u, wr, wc, fr, fq);
        else if (pn == 7) run<4>(acc, u, wr, wc, fr, fq);
        else if (pn < 10) run<5>(acc, u, wr, wc, fr, fq);
        else if (pn < 12) run<6>(acc, u, wr, wc, fr, fq);
        else run<7>(acc, u, wr, wc, fr, fq);
    }
};


struct EpiMem {
    static constexpr bool PERM = false, AFTER_DRAIN = false;
    bf16_t *KM, *VMT, *VMN; float* out;
    __device__ __forceinline__ void operator()(const f32x4 (&acc)[2][2][4][2], const pg8::Unit& u, int wr, int wc, int fr, int fq) const {
        asm volatile("" : "+v"(fr), "+v"(fq));
        const int pn = u.pn;
        EPI_LOOP_BEGIN
            if (pn < 4) { const int col = pn * 256 + c;
                *(f32x4*)(out + OUT_PMK + (size_t)row * 1024 + col) = v; st_bf4(KM + (size_t)row * 1024 + col, v);
            } else { const int col = (pn - 4) * 256 + c; const int nb = row >> 8, key = row & 255;
                *(f32x4*)(out + OUT_PMV + (size_t)row * 1024 + col) = v; st_bf4(VMN + (size_t)row * 1024 + col, v);
                bf16_t* p = VMT + ((size_t)nb * 1024 + col) * 256 + key;
                p[0] = f2bf(v[0]); p[256] = f2bf(v[1]); p[512] = f2bf(v[2]); p[768] = f2bf(v[3]);
            }
        EPI_LOOP_END
    }
};

struct EpiPlain {
    static constexpr bool PERM = true, AFTER_DRAIN = false;
    bf16_t* O; int ldc; float scale;
    __device__ __forceinline__ void operator()(const f32x4 (&acc)[2][2][4][2], const pg8::Unit& u, int wr, int wc, int fr, int fq) const {
        asm volatile("" : "+v"(fr), "+v"(fq));
#pragma unroll
        for (int ai = 0; ai < 2; ++ai)
#pragma unroll
            for (int m = 0; m < 4; ++m) { const int row = u.pm * 256 + ai * 128 + wr * 64 + m * 16 + fr;
#pragma unroll
                for (int bj = 0; bj < 2; ++bj) st_bf8(O + (size_t)row * ldc + u.pn * 256 + bj * 128 + wc * 32 + 8 * fq, acc[ai][bj][m][0] * scale, acc[ai][bj][m][1] * scale);
                asm volatile("" ::: "memory"); }
    }
};

struct EpiSwiglu {
    static constexpr bool PERM = true, AFTER_DRAIN = false;
    bf16_t* HID;
    __device__ __forceinline__ void operator()(const f32x4 (&acc)[2][2][4][2], const pg8::Unit& u, int wr, int wc, int fr, int fq) const {
        asm volatile("" : "+v"(fr), "+v"(fq));
#pragma unroll
        for (int ai = 0; ai < 2; ++ai)
#pragma unroll
            for (int m = 0; m < 4; ++m) {
                const int row = u.pm * 256 + ai * 128 + wr * 64 + m * 16 + fr; f32x4 s[2];
#pragma unroll
                for (int n = 0; n < 2; ++n) { const f32x4 g = acc[ai][0][m][n], up = acc[ai][1][m][n];
                    s[n][0] = silu_f(g[0]) * up[0]; s[n][1] = silu_f(g[1]) * up[1]; s[n][2] = silu_f(g[2]) * up[2]; s[n][3] = silu_f(g[3]) * up[3]; }
                st_bf8(HID + (size_t)row * DFF + u.pn * 128 + wc * 32 + 8 * fq, s[0], s[1]);
                asm volatile("" ::: "memory");
            }
    }
};

struct OrderMem {
    pg8::StaticOrder S;
    __device__ bool next(int i, pg8::Unit& u) const { if (!S.next(i, u)) return false; u.pn += (u.pm >= SEQ / 256) ? 4 : 0; return true; }
    __device__ __forceinline__ void a_ready(const pg8::Unit&) const {}
    __device__ __forceinline__ void done(const pg8::Unit&) const {}
};
struct EpiPlainM {
    static constexpr bool PERM = true, AFTER_DRAIN = false;
    bf16_t* O;
    __device__ __forceinline__ void operator()(const f32x4 (&acc)[2][2][4][2], const pg8::Unit& u, int wr, int wc, int fr, int fq) const {
        asm volatile("" : "+v"(fr), "+v"(fq));
#pragma unroll
        for (int ai = 0; ai < 2; ++ai)
#pragma unroll
            for (int m = 0; m < 4; ++m) { const int row = u.pm * 256 + ai * 128 + wr * 64 + m * 16 + fr;
#pragma unroll
                for (int bj = 0; bj < 2; ++bj) st_bf8(O + (size_t)row * 1024 + (u.pn & 3) * 256 + bj * 128 + wc * 32 + 8 * fq, acc[ai][bj][m][0], acc[ai][bj][m][1]);
                asm volatile("" ::: "memory"); }
    }
};
struct EpiSoftmax {
    static constexpr bool PERM = true, AFTER_DRAIN = false;
    bf16_t* O; LAS unsigned char* xl;
    __device__ __forceinline__ void operator()(const f32x4 (&acc_)[2][2][4][2], const pg8::Unit& u, int wr, int wc, int fr, int fq) const {
        asm volatile("" : "+v"(fr), "+v"(fq));
        f32x4 (&acc)[2][2][4][2] = const_cast<f32x4 (&)[2][2][4][2]>(acc_);
        LAS float* MX = (LAS float*)xl; LAS float* SM = (LAS float*)(xl + 4096);
#pragma unroll
        for (int ai = 0; ai < 2; ++ai)
#pragma unroll
            for (int m = 0; m < 4; ++m) { float mx = -INFINITY;
#pragma unroll
                for (int bj = 0; bj < 2; ++bj)
#pragma unroll
                    for (int n = 0; n < 2; ++n) { const f32x4 v = acc[ai][bj][m][n]; mx = fmaxf(fmaxf(mx, fmaxf(v[0], v[1])), fmaxf(v[2], v[3])); }
                mx = fmaxf(mx, __shfl_xor(mx, 16)); mx = fmaxf(mx, __shfl_xor(mx, 32));
                if (fq == 0) MX[(ai * 128 + wr * 64 + m * 16 + fr) * 4 + wc] = mx; }
        asm volatile("s_waitcnt lgkmcnt(0)" ::: "memory"); __builtin_amdgcn_s_barrier(); asm volatile("" ::: "memory");
#pragma unroll
        for (int ai = 0; ai < 2; ++ai)
#pragma unroll
            for (int m = 0; m < 4; ++m) { const f32x4 mv = *(const LAS f32x4*)(MX + (ai * 128 + wr * 64 + m * 16 + fr) * 4);
                const float mx = fmaxf(fmaxf(mv[0], mv[1]), fmaxf(mv[2], mv[3])); float sum = 0.f;
#pragma unroll
                for (int bj = 0; bj < 2; ++bj)
#pragma unroll
                    for (int n = 0; n < 2; ++n) { f32x4 v = acc[ai][bj][m][n];
                        v[0] = __builtin_amdgcn_exp2f(v[0] - mx); v[1] = __builtin_amdgcn_exp2f(v[1] - mx); v[2] = __builtin_amdgcn_exp2f(v[2] - mx); v[3] = __builtin_amdgcn_exp2f(v[3] - mx);
                        acc[ai][bj][m][n] = v; sum += (v[0] + v[1]) + (v[2] + v[3]); }
                sum += __shfl_xor(sum, 16); sum += __shfl_xor(sum, 32);
                if (fq == 0) SM[(ai * 128 + wr * 64 + m * 16 + fr) * 4 + wc] = sum; }
        asm volatile("s_waitcnt lgkmcnt(0)" ::: "memory"); __builtin_amdgcn_s_barrier(); asm volatile("" ::: "memory");
#pragma unroll
        for (int ai = 0; ai < 2; ++ai)
#pragma unroll
            for (int m = 0; m < 4; ++m) { const int rl = ai * 128 + wr * 64 + m * 16 + fr; const f32x4 sv = *(const LAS f32x4*)(SM + rl * 4);
                const float inv = 1.f / ((sv[0] + sv[1]) + (sv[2] + sv[3])); const size_t row = (size_t)u.pm * 256 + rl;
#pragma unroll
                for (int bj = 0; bj < 2; ++bj) st_bf8(O + row * 1024 + (u.pn & 3) * 256 + bj * 128 + wc * 32 + 8 * fq, acc[ai][bj][m][0] * inv, acc[ai][bj][m][1] * inv); }
    }
};
__device__ __forceinline__ void pre_tile(const bf16_t* A, int lda, const bf16_t* Bt, int ldb, bf16_t* O, int ldo, float scale, int lane) {
    const int r = lane & 31, h = lane >> 5; f32x16 a0, a1;
#pragma unroll
    for (int i = 0; i < 16; ++i) { a0[i] = 0.f; a1[i] = 0.f; }
#pragma unroll
    for (int s = 0; s < 16; s += 2) {
        a0 = MFMA32(*(const bf16x8*)(A + (size_t)r * lda + 16 * s + 8 * h), *(const bf16x8*)(Bt + (size_t)r * ldb + 16 * s + 8 * h), a0);
        a1 = MFMA32(*(const bf16x8*)(A + (size_t)r * lda + 16 * (s + 1) + 8 * h), *(const bf16x8*)(Bt + (size_t)r * ldb + 16 * (s + 1) + 8 * h), a1); }
#pragma unroll
    for (int i = 0; i < 16; ++i) O[(size_t)crow(i, h) * ldo + r] = f2bf((a0[i] + a1[i]) * scale);
}
__device__ __forceinline__ void tr_item(const float* src, int lds_, bf16_t* dst, int ldd, int k0, int n0, int drow0, LAS float* scr, int lane) {
#pragma unroll
    for (int i = 0; i < 8; ++i) { const int kk = 8 * i + (lane >> 3), n4 = (lane & 7) * 4;
        const f32x4 w4 = __builtin_nontemporal_load((const f32x4*)(src + (size_t)(k0 + kk) * lds_ + n0 + n4));
        scr[kk * 33 + n4] = w4[0]; scr[kk * 33 + n4 + 1] = w4[1]; scr[kk * 33 + n4 + 2] = w4[2]; scr[kk * 33 + n4 + 3] = w4[3]; }
    LDS_WAIT();
    const int c = lane & 7;
#pragma unroll
    for (int j = 0; j < 4; ++j) { const int n = (lane >> 3) + 8 * j; const LAS float* s = scr + (8 * c) * 33 + n;
        u32x4 o; o.x = pk2(s[0 * 33], s[1 * 33]); o.y = pk2(s[2 * 33], s[3 * 33]); o.z = pk2(s[4 * 33], s[5 * 33]); o.w = pk2(s[6 * 33], s[7 * 33]);
        *(u32x4*)(dst + (size_t)(drow0 + n) * ldd + k0 + 8 * c) = o; }
    LDS_WAIT();
}
template <int NR>
__device__ __forceinline__ void rms_rows_bf16(const float* const (&xrow)[NR], const f32x4 (&gg)[2][2], bf16_t* const (&orow)[NR], int lane) {
    f32x4 v[NR][2][2]; float s[NR];
#pragma unroll
    for (int q = 0; q < NR; ++q)
#pragma unroll
        for (int j = 0; j < 2; ++j)
#pragma unroll
            for (int hf = 0; hf < 2; ++hf) v[q][j][hf] = __builtin_nontemporal_load((const f32x4*)(xrow[q] + 512 * j + 8 * lane + 4 * hf));
#pragma unroll
    for (int q = 0; q < NR; ++q) { s[q] = 0.f;
#pragma unroll
        for (int j = 0; j < 2; ++j)
#pragma unroll
            for (int hf = 0; hf < 2; ++hf) s[q] += (v[q][j][hf][0] * v[q][j][hf][0] + v[q][j][hf][1] * v[q][j][hf][1]) + (v[q][j][hf][2] * v[q][j][hf][2] + v[q][j][hf][3] * v[q][j][hf][3]); }
#pragma unroll
    for (int q = 0; q < NR; ++q) { const float rstd = rsqrtf(wave_sum(s[q]) * (1.f / DM) + EPS);
#pragma unroll
        for (int j = 0; j < 2; ++j) { const f32x4 a = v[q][j][0] * rstd * gg[j][0], b2 = v[q][j][1] * rstd * gg[j][1]; u32x4 w_;
            w_.x = pk2(a[0], a[1]); w_.y = pk2(a[2], a[3]); w_.z = pk2(b2[0], b2[1]); w_.w = pk2(b2[2], b2[3]);
            *(u32x4*)(orow[q] + 512 * j + 8 * lane) = w_; } }
}
struct RowGains { f32x4 gp[2][2], gn[2][2]; bool has_next; };
__device__ __forceinline__ RowGains load_gains(const float* gpost, const float* gnext, int lane) {
    RowGains g; g.has_next = gnext != nullptr;
#pragma unroll
    for (int j = 0; j < 2; ++j)
#pragma unroll
        for (int hf = 0; hf < 2; ++hf) { g.gp[j][hf] = *(const f32x4*)(gpost + 512 * j + 8 * lane + 4 * hf);
            g.gn[j][hf] = gnext ? *(const f32x4*)(gnext + 512 * j + 8 * lane + 4 * hf) : (f32x4){0.f, 0.f, 0.f, 0.f}; }
    return g;
}
__device__ __forceinline__ void unpack8(u32x4 w, f32x4& a, f32x4& b) {
    a[0] = bf2f(w.x & 0xffffu); a[1] = bf2f(w.x >> 16); a[2] = bf2f(w.y & 0xffffu); a[3] = bf2f(w.y >> 16);
    b[0] = bf2f(w.z & 0xffffu); b[1] = bf2f(w.z >> 16); b[2] = bf2f(w.w & 0xffffu); b[3] = bf2f(w.w >> 16); }
__device__ __forceinline__ float sq4(f32x4 v) { return (v[0] * v[0] + v[1] * v[1]) + (v[2] * v[2] + v[3] * v[3]); }
template <int NR, bool XI16, bool XO16>
__device__ __forceinline__ void rowpass_rows(const bf16_t* const (&urow)[NR], const void* const (&xin)[NR], const RowGains& G, void* const (&xout)[NR], bf16_t* const (&hout)[NR], int lane) {
    f32x4 uu[NR][2][2], xx[NR][2][2]; float s[NR], s2[NR];
#pragma unroll
    for (int q = 0; q < NR; ++q)
#pragma unroll
        for (int j = 0; j < 2; ++j) { const int c0 = 512 * j + 8 * lane;
            unpack8(__builtin_nontemporal_load((const u32x4*)(urow[q] + c0)), uu[q][j][0], uu[q][j][1]);
            if constexpr (XI16) unpack8(__builtin_nontemporal_load((const u32x4*)((const bf16_t*)xin[q] + c0)), xx[q][j][0], xx[q][j][1]);
            else { xx[q][j][0] = __builtin_nontemporal_load((const f32x4*)((const float*)xin[q] + c0)); xx[q][j][1] = __builtin_nontemporal_load((const f32x4*)((const float*)xin[q] + c0 + 4)); } }
#pragma unroll
    for (int q = 0; q < NR; ++q) s[q] = (sq4(uu[q][0][0]) + sq4(uu[q][0][1])) + (sq4(uu[q][1][0]) + sq4(uu[q][1][1]));
#pragma unroll
    for (int q = 0; q < NR; ++q) { const float rstd = rsqrtf(wave_sum(s[q]) * (1.f / DM) + EPS); s2[q] = 0.f;
#pragma unroll
        for (int j = 0; j < 2; ++j) { const int c0 = 512 * j + 8 * lane;
#pragma unroll
            for (int hf = 0; hf < 2; ++hf) { uu[q][j][hf] = xx[q][j][hf] + uu[q][j][hf] * rstd * G.gp[j][hf]; s2[q] += sq4(uu[q][j][hf]); }
            if constexpr (XO16) { u32x4 w_; w_.x = pk2(uu[q][j][0][0], uu[q][j][0][1]); w_.y = pk2(uu[q][j][0][2], uu[q][j][0][3]); w_.z = pk2(uu[q][j][1][0], uu[q][j][1][1]); w_.w = pk2(uu[q][j][1][2], uu[q][j][1][3]);
                __builtin_nontemporal_store(w_, (u32x4*)((bf16_t*)xout[q] + c0)); }
            else { __builtin_nontemporal_store(uu[q][j][0], (f32x4*)((float*)xout[q] + c0)); __builtin_nontemporal_store(uu[q][j][1], (f32x4*)((float*)xout[q] + c0 + 4)); } } }
    if (G.has_next) {
#pragma unroll
        for (int q = 0; q < NR; ++q) { const float r2 = rsqrtf(wave_sum(s2[q]) * (1.f / DM) + EPS);
#pragma unroll
            for (int j = 0; j < 2; ++j) { u32x4 w_; const f32x4 a = uu[q][j][0] * r2 * G.gn[j][0], b2 = uu[q][j][1] * r2 * G.gn[j][1];
                w_.x = pk2(a[0], a[1]); w_.y = pk2(a[2], a[3]); w_.z = pk2(b2[0], b2[1]); w_.w = pk2(b2[2], b2[3]);
                *(u32x4*)(hout[q] + 512 * j + 8 * lane) = w_; } }
    }
}
__device__ __forceinline__ const float* xrow_ptr(const float* xp, const float* xs, int m) { return m < MP ? xp + (size_t)m * DM : xs + (size_t)(m - MP) * DM; }

constexpr int BA_KP = 144, BA_VP = 80, BA_VOFF = 32 * BA_KP, BA_WAVE = BA_VOFF + 64 * BA_VP, BA_TAB = 8 * 640 * 4;
__device__ __forceinline__ void band_core(const bf16_t* Qg, const bf16_t* Kp, int ldk, const bf16_t* VTp, int ldvt, int j0, int j1,
                                          const LAS float* rev, int qpos0, bf16_t* Op, LAS unsigned char* wl, int lane) {
    const int r = lane & 31, h = lane >> 5;
    bf16x8 qf[4];
#pragma unroll
    for (int s = 0; s < 4; ++s) qf[s] = *(const bf16x8*)(Qg + (size_t)r * 512 + 16 * s + 8 * h);
    f32x16 o[2];
#pragma unroll
    for (int dt = 0; dt < 2; ++dt)
#pragma unroll
        for (int i = 0; i < 16; ++i) o[dt][i] = 0.f;
    float m_run = -INFINITY, l_run = 0.f;
    const int krl = lane >> 3, kpc = lane & 7, vrl = lane >> 2, vpc = lane & 3;
    u32x4 kst[4], vst[4];
#pragma unroll
    for (int i = 0; i < 4; ++i) { kst[i] = *(const u32x4*)(Kp + (long)(j0 + krl + 8 * i) * ldk + 8 * kpc); vst[i] = *(const u32x4*)(VTp + (long)(vrl + 16 * i) * ldvt + j0 + 8 * vpc); }
    for (int jt = j0; jt < j1; jt += 32) {
#pragma unroll
        for (int i = 0; i < 4; ++i) { *(LAS u32x4*)(wl + (krl + 8 * i) * BA_KP + 16 * kpc) = kst[i]; *(LAS u32x4*)(wl + BA_VOFF + (vrl + 16 * i) * BA_VP + 16 * vpc) = vst[i]; }
        { const int jn = (jt + 32 < j1) ? jt + 32 : jt;
#pragma unroll
          for (int i = 0; i < 4; ++i) { kst[i] = *(const u32x4*)(Kp + (long)(jn + krl + 8 * i) * ldk + 8 * kpc); vst[i] = *(const u32x4*)(VTp + (long)(vrl + 16 * i) * ldvt + jn + 8 * vpc); } }
        f32x16 sacc;
#pragma unroll
        for (int i = 0; i < 16; ++i) sacc[i] = 0.f;
#pragma unroll
        for (int s = 0; s < 4; ++s) sacc = MFMA32(*(const LAS bf16x8*)(wl + r * BA_KP + (16 * s + 8 * h) * 2), qf[s], sacc);
        const LAS float* rb = rev + (576 - qpos0 - r + jt + 4 * h);
        float mx = -INFINITY;
#pragma unroll
        for (int i = 0; i < 16; ++i) { const float t = sacc[i] + rb[(i & 3) + 8 * (i >> 2)]; sacc[i] = t; mx = fmaxf(mx, t); }
        mx = fmaxf(mx, __shfl_xor(mx, 32));
        const float m_new = fmaxf(m_run, mx); const float alpha = __builtin_amdgcn_exp2f(m_run - m_new); m_run = m_new;
        float ps = 0.f;
#pragma unroll
        for (int i = 0; i < 16; ++i) { const float p = __builtin_amdgcn_exp2f(sacc[i] - m_new); sacc[i] = p; ps += p; }
        l_run = l_run * alpha + ps;
        if (__any(alpha != 1.f)) {
#pragma unroll
            for (int dt = 0; dt < 2; ++dt)
#pragma unroll
                for (int i = 0; i < 16; ++i) o[dt][i] *= alpha;
        }
        bf16x8 pf[2];
        pf[0] = pack8(sacc[0], sacc[1], sacc[2], sacc[3], sacc[4], sacc[5], sacc[6], sacc[7]);
        pf[1] = pack8(sacc[8], sacc[9], sacc[10], sacc[11], sacc[12], sacc[13], sacc[14], sacc[15]);
#pragma unroll
        for (int dt = 0; dt < 2; ++dt)
#pragma unroll
            for (int s2 = 0; s2 < 2; ++s2) {
                const LAS unsigned char* vp = wl + BA_VOFF + (32 * dt + r) * BA_VP + (16 * s2 + 4 * h) * 2;
                const s16x4 lo = *(const LAS s16x4*)vp, hi = *(const LAS s16x4*)(vp + 16);
                bf16x8 vf; vf[0] = lo[0]; vf[1] = lo[1]; vf[2] = lo[2]; vf[3] = lo[3]; vf[4] = hi[0]; vf[5] = hi[1]; vf[6] = hi[2]; vf[7] = hi[3];
                o[dt] = MFMA32(vf, pf[s2], o[dt]);
            }
    }
    const float l = l_run + __shfl_xor(l_run, 32); const float inv = 1.f / l;
#pragma unroll
    for (int dt = 0; dt < 2; ++dt)
#pragma unroll
        for (int g = 0; g < 4; ++g) {
            f32x4 v; v[0] = o[dt][4 * g] * inv; v[1] = o[dt][4 * g + 1] * inv; v[2] = o[dt][4 * g + 2] * inv; v[3] = o[dt][4 * g + 3] * inv;
            st_bf4(Op + (size_t)r * 1024 + 32 * dt + 8 * g + 4 * h, v);
        }
}

__device__ __forceinline__ void band_core64(const bf16_t* Qg, const bf16_t* Kp, int ldk, const bf16_t* VTp, int ldvt, int j0, int j1,
                                            const LAS float* rev, bf16_t* Op, LAS unsigned char* wl, int lane) {
    const int r = lane & 31, h = lane >> 5;
    bf16x8 qf[2][4];
    {
        const int qr_ = lane >> 3, qp_ = lane & 7; u32x4 qs[8];
#pragma unroll
        for (int i = 0; i < 8; ++i) qs[i] = *(const u32x4*)(Qg + (size_t)(qr_ + 8 * i) * 512 + 8 * qp_);
#pragma unroll
        for (int i = 0; i < 8; ++i) *(LAS u32x4*)(wl + (qr_ + 8 * i) * 144 + 16 * qp_) = qs[i];
#pragma unroll
        for (int qt = 0; qt < 2; ++qt)
#pragma unroll
            for (int s = 0; s < 4; ++s) qf[qt][s] = *(const LAS bf16x8*)(wl + (32 * qt + r) * 144 + (16 * s + 8 * h) * 2);
    }
    f32x16 o[2][2];
#pragma unroll
    for (int qt = 0; qt < 2; ++qt)
#pragma unroll
        for (int dt = 0; dt < 2; ++dt)
#pragma unroll
            for (int i = 0; i < 16; ++i) o[qt][dt][i] = 0.f;
    float m_run[2] = {-INFINITY, -INFINITY}, l_run[2] = {0.f, 0.f};
    const int krl = lane >> 3, kpc = lane & 7, vrl = lane >> 2, vpc = lane & 3;
    u32x4 kst[4], vst[4];
#pragma unroll
    for (int i = 0; i < 4; ++i) { kst[i] = *(const u32x4*)(Kp + (long)(j0 + krl + 8 * i) * ldk + 8 * kpc); vst[i] = *(const u32x4*)(VTp + (long)(vrl + 16 * i) * ldvt + j0 + 8 * vpc); }
    for (int jt = j0; jt < j1; jt += 32) {
#pragma unroll
        for (int i = 0; i < 4; ++i) { *(LAS u32x4*)(wl + (krl + 8 * i) * BA_KP + 16 * kpc) = kst[i]; *(LAS u32x4*)(wl + BA_VOFF + (vrl + 16 * i) * BA_VP + 16 * vpc) = vst[i]; }
        { const int jn = (jt + 32 < j1) ? jt + 32 : jt;
#pragma unroll
          for (int i = 0; i < 4; ++i) { kst[i] = *(const u32x4*)(Kp + (long)(jn + krl + 8 * i) * ldk + 8 * kpc); vst[i] = *(const u32x4*)(VTp + (long)(vrl + 16 * i) * ldvt + jn + 8 * vpc); } }
        f32x16 sa[2];
#pragma unroll
        for (int i = 0; i < 16; ++i) { sa[0][i] = 0.f; sa[1][i] = 0.f; }
#pragma unroll
        for (int s = 0; s < 4; ++s) { const bf16x8 kf = *(const LAS bf16x8*)(wl + r * BA_KP + (16 * s + 8 * h) * 2);
            sa[0] = MFMA32(kf, qf[0][s], sa[0]); sa[1] = MFMA32(kf, qf[1][s], sa[1]); }
        bf16x8 pf[2][2];
#pragma unroll
        for (int qt = 0; qt < 2; ++qt) {
            const LAS float* rb = rev + (64 - 32 * qt - r + jt + 4 * h);
            float mx = -INFINITY;
#pragma unroll
            for (int i = 0; i < 16; ++i) { const float t = sa[qt][i] + rb[(i & 3) + 8 * (i >> 2)]; sa[qt][i] = t; mx = fmaxf(mx, t); }
            mx = fmaxf(mx, __shfl_xor(mx, 32));
            const float m_new = fmaxf(m_run[qt], mx); const float alpha = __builtin_amdgcn_exp2f(m_run[qt] - m_new); m_run[qt] = m_new;
            float ps = 0.f;
#pragma unroll
            for (int i = 0; i < 16; ++i) { const float p = __builtin_amdgcn_exp2f(sa[qt][i] - m_new); sa[qt][i] = p; ps += p; }
            l_run[qt] = l_run[qt] * alpha + ps;
            if (__any(alpha != 1.f)) {
#pragma unroll
                for (int dt = 0; dt < 2; ++dt)
#pragma unroll
                    for (int i = 0; i < 16; ++i) o[qt][dt][i] *= alpha;
            }
            pf[qt][0] = pack8(sa[qt][0], sa[qt][1], sa[qt][2], sa[qt][3], sa[qt][4], sa[qt][5], sa[qt][6], sa[qt][7]);
            pf[qt][1] = pack8(sa[qt][8], sa[qt][9], sa[qt][10], sa[qt][11], sa[qt][12], sa[qt][13], sa[qt][14], sa[qt][15]);
        }
#pragma unroll
        for (int dt = 0; dt < 2; ++dt)
#pragma unroll
            for (int s2 = 0; s2 < 2; ++s2) {
                const LAS unsigned char* vp = wl + BA_VOFF + (32 * dt + r) * BA_VP + (16 * s2 + 4 * h) * 2;
                const s16x4 lo = *(const LAS s16x4*)vp, hi = *(const LAS s16x4*)(vp + 16);
                bf16x8 vf; vf[0] = lo[0]; vf[1] = lo[1]; vf[2] = lo[2]; vf[3] = lo[3]; vf[4] = hi[0]; vf[5] = hi[1]; vf[6] = hi[2]; vf[7] = hi[3];
                o[0][dt] = MFMA32(vf, pf[0][s2], o[0][dt]); o[1][dt] = MFMA32(vf, pf[1][s2], o[1][dt]);
            }
    }
#pragma unroll
    for (int qt = 0; qt < 2; ++qt) {
        const float l = l_run[qt] + __shfl_xor(l_run[qt], 32); const float inv = 1.f / l;
#pragma unroll
        for (int dt = 0; dt < 2; ++dt)
#pragma unroll
            for (int g = 0; g < 4; ++g) { u32x2 w2; w2.x = pk2(o[qt][dt][4 * g] * inv, o[qt][dt][4 * g + 1] * inv); w2.y = pk2(o[qt][dt][4 * g + 2] * inv, o[qt][dt][4 * g + 3] * inv);
                *(LAS u32x2*)(wl + (32 * qt + r) * 144 + (32 * dt + 8 * g + 4 * h) * 2) = w2; }
    }
#pragma unroll
    for (int k = 0; k < 8; ++k) { const int p = lane + 64 * k, row = p >> 3, pc = p & 7;
        *(u32x4*)(Op + (size_t)row * 1024 + 8 * pc) = *(const LAS u32x4*)(wl + row * 144 + 16 * pc); }
}

constexpr int GA_WAVE = 64 * 144;
__device__ __forceinline__ void gla_wave_a(LAS unsigned char* wl, const float* LAT, const bf16_t* KBT, const bf16_t* VBT, float* BC, float* DST, float* DEC, int unit, int lane) {
    const int c = unit & (NCH - 1), bh = unit >> 8, hb = bh & 3, b = bh >> 2;
    const size_t row0 = (size_t)b * SEQ + (size_t)c * 64;
    const int r = lane & 31, h = lane >> 5;
    float bc[64];
    { const float* lp = LAT + ((size_t)bh * 64 + lane) * SEQ + c * 64;
#pragma unroll
      for (int i = 0; i < 16; ++i) { const f32x4 v = *(const f32x4*)(lp + 4 * i); bc[4 * i] = v[0]; bc[4 * i + 1] = v[1]; bc[4 * i + 2] = v[2]; bc[4 * i + 3] = v[3]; } }
    u32x4 kk[8];
    { const bf16_t* kp = KBT + ((size_t)bh * 64 + lane) * SEQ + c * 64;
#pragma unroll
      for (int i = 0; i < 8; ++i) kk[i] = *(const u32x4*)(kp + 8 * i); }
#pragma unroll
    for (int t = 1; t < 64; ++t) bc[t] += bc[t - 1];
    { float* bp = BC + row0 * 256 + hb * 64 + lane;
#pragma unroll
      for (int t = 0; t < 64; ++t) bp[(size_t)t * 256] = bc[t]; }
    const float bl = bc[63];
    DEC[(size_t)unit * 64 + lane] = __expf(bl);
#pragma unroll
    for (int i = 0; i < 8; ++i) { u32x4 w;
#pragma unroll
        for (int e = 0; e < 4; ++e) { const unsigned kw = kk[i][e]; const int t = 8 * i + 2 * e;
            w[e] = pk2(bf2f(kw & 0xffffu) * __expf(bl - bc[t]), bf2f(kw >> 16) * __expf(bl - bc[t + 1])); }
        *(LAS u32x4*)(wl + lane * 144 + 16 * i) = w; }
    const bf16_t* vbase = VBT + ((size_t)bh * 128) * SEQ + c * 64;
    float* dst = DST + (size_t)unit * 8192;
#pragma unroll 1
    for (int dvt = 0; dvt < 4; ++dvt) {
        f32x16 a0, a1;
#pragma unroll
        for (int i = 0; i < 16; ++i) { a0[i] = 0.f; a1[i] = 0.f; }
#pragma unroll
        for (int s = 0; s < 4; ++s) {
            const bf16x8 va = *(const bf16x8*)(vbase + (size_t)(32 * dvt + r) * SEQ + 16 * s + 8 * h);
            a0 = MFMA32(va, *(const LAS bf16x8*)(wl + r * 144 + (16 * s + 8 * h) * 2), a0);
            a1 = MFMA32(va, *(const LAS bf16x8*)(wl + (32 + r) * 144 + (16 * s + 8 * h) * 2), a1);
        }
#pragma unroll
        for (int i = 0; i < 16; ++i) { float* p = dst + (32 * dvt + crow(i, h)) * 64 + r; p[0] = a0[i]; p[32] = a1[i]; }
    }
}

constexpr int GB_P = 272, GB_WAVE = 18176;
__device__ __forceinline__ void gla_wave_b(LAS unsigned char* wl, const float* BC, const bf16_t* QB, const bf16_t* KB, const bf16_t* VBT, const bf16_t* SST, const bf16_t* RS, const float* ggla, bf16_t* Y, int unit, int lane) {
    const int c = unit & (NCH - 1), bh = unit >> 8, hb = bh & 3, b = bh >> 2;
    const size_t row0 = (size_t)b * SEQ + (size_t)c * 64;
    const int r = lane & 31, h = lane >> 5;
    bf16x8 qt[2][4], kt[2][4];
    {
        const int br_ = lane >> 4, bp_ = lane & 15, qr_ = lane >> 3, qp_ = lane & 7;
        f32x4 bst[2][8]; u32x4 qst[2][4], kst[2][4];
#pragma unroll
        for (int rt = 0; rt < 2; ++rt) {
#pragma unroll
            for (int i = 0; i < 8; ++i) bst[rt][i] = *(const f32x4*)(BC + (row0 + 32 * rt + br_ + 4 * i) * 256 + hb * 64 + 4 * bp_);
#pragma unroll
            for (int i = 0; i < 4; ++i) { qst[rt][i] = *(const u32x4*)(QB + (row0 + 32 * rt + qr_ + 8 * i) * 256 + hb * 64 + 8 * qp_); kst[rt][i] = *(const u32x4*)(KB + (row0 + 32 * rt + qr_ + 8 * i) * 256 + hb * 64 + 8 * qp_); }
        }
#pragma unroll
        for (int rt = 0; rt < 2; ++rt) {
#pragma unroll
            for (int i = 0; i < 8; ++i) *(LAS f32x4*)(wl + (br_ + 4 * i) * 272 + 16 * bp_) = bst[rt][i];
#pragma unroll
            for (int i = 0; i < 4; ++i) { *(LAS u32x4*)(wl + 8704 + (qr_ + 8 * i) * 144 + 16 * qp_) = qst[rt][i]; *(LAS u32x4*)(wl + 13312 + (qr_ + 8 * i) * 144 + 16 * qp_) = kst[rt][i]; }
#pragma unroll
            for (int s = 0; s < 4; ++s) {
                const f32x4 b0 = *(const LAS f32x4*)(wl + r * 272 + (16 * s + 8 * h) * 4), b1 = *(const LAS f32x4*)(wl + r * 272 + (16 * s + 8 * h) * 4 + 16);
                const u32x4 qw = *(const LAS u32x4*)(wl + 8704 + r * 144 + (16 * s + 8 * h) * 2), kw = *(const LAS u32x4*)(wl + 13312 + r * 144 + (16 * s + 8 * h) * 2);
                float e[8], qv[8], kv[8];
#pragma unroll
                for (int j = 0; j < 4; ++j) { e[j] = __expf(b0[j]); e[4 + j] = __expf(b1[j]); }
#pragma unroll
                for (int j = 0; j < 4; ++j) { qv[2 * j] = bf2f(qw[j] & 0xffffu) * e[2 * j]; qv[2 * j + 1] = bf2f(qw[j] >> 16) * e[2 * j + 1];
                    kv[2 * j] = bf2f(kw[j] & 0xffffu) * __builtin_amdgcn_rcpf(e[2 * j]); kv[2 * j + 1] = bf2f(kw[j] >> 16) * __builtin_amdgcn_rcpf(e[2 * j + 1]); }
                qt[rt][s] = pack8(qv[0], qv[1], qv[2], qv[3], qv[4], qv[5], qv[6], qv[7]);
                kt[rt][s] = pack8(kv[0], kv[1], kv[2], kv[3], kv[4], kv[5], kv[6], kv[7]);
            }
        }
    }
    f32x16 t00, t01, t11;
#pragma unroll
    for (int i = 0; i < 16; ++i) { t00[i] = 0.f; t01[i] = 0.f; t11[i] = 0.f; }
#pragma unroll
    for (int s = 0; s < 4; ++s) { t00 = MFMA32(kt[0][s], qt[0][s], t00); t01 = MFMA32(kt[0][s], qt[1][s], t01); t11 = MFMA32(kt[1][s], qt[1][s], t11); }
#pragma unroll
    for (int i = 0; i < 16; ++i) { const bool keep = crow(i, h) <= r; t00[i] = keep ? t00[i] : 0.f; t11[i] = keep ? t11[i] : 0.f; }
    bf16x8 p00[2], p01[2], p11[2];
#pragma unroll
    for (int s2 = 0; s2 < 2; ++s2) {
        p00[s2] = pack8(t00[8 * s2], t00[8 * s2 + 1], t00[8 * s2 + 2], t00[8 * s2 + 3], t00[8 * s2 + 4], t00[8 * s2 + 5], t00[8 * s2 + 6], t00[8 * s2 + 7]);
        p01[s2] = pack8(t01[8 * s2], t01[8 * s2 + 1], t01[8 * s2 + 2], t01[8 * s2 + 3], t01[8 * s2 + 4], t01[8 * s2 + 5], t01[8 * s2 + 6], t01[8 * s2 + 7]);
        p11[s2] = pack8(t11[8 * s2], t11[8 * s2 + 1], t11[8 * s2 + 2], t11[8 * s2 + 3], t11[8 * s2 + 4], t11[8 * s2 + 5], t11[8 * s2 + 6], t11[8 * s2 + 7]);
    }
    const bf16_t* vbase = VBT + ((size_t)bh * 128) * SEQ + c * 64;
    const bf16_t* sbase = SST + (size_t)unit * 8192;
    float ss0 = 0.f, ss1 = 0.f;
#pragma unroll 1
    for (int dvt = 0; dvt < 4; ++dvt) {
        f32x16 o0, o1;
#pragma unroll
        for (int i = 0; i < 16; ++i) { o0[i] = 0.f; o1[i] = 0.f; }
#pragma unroll
        for (int s = 0; s < 4; ++s) { const bf16x8 sa = *(const bf16x8*)(sbase + (32 * dvt + r) * 64 + 16 * s + 8 * h); o0 = MFMA32(sa, qt[0][s], o0); o1 = MFMA32(sa, qt[1][s], o1); }
#pragma unroll
        for (int jt = 0; jt < 2; ++jt)
#pragma unroll
            for (int s2 = 0; s2 < 2; ++s2) {
                const bf16_t* vp = vbase + (size_t)(32 * dvt + r) * SEQ + 32 * jt + 16 * s2 + 4 * h;
                const s16x4 lo = *(const s16x4*)vp, hi = *(const s16x4*)(vp + 8);
                bf16x8 vf; vf[0] = lo[0]; vf[1] = lo[1]; vf[2] = lo[2]; vf[3] = lo[3]; vf[4] = hi[0]; vf[5] = hi[1]; vf[6] = hi[2]; vf[7] = hi[3];
                if (jt == 0) { o0 = MFMA32(vf, p00[s2], o0); o1 = MFMA32(vf, p01[s2], o1); } else o1 = MFMA32(vf, p11[s2], o1);
            }
#pragma unroll
        for (int i = 0; i < 16; ++i) { ss0 += o0[i] * o0[i]; ss1 += o1[i] * o1[i]; }
#pragma unroll
        for (int g = 0; g < 4; ++g) { u32x2 w0, w1; w0.x = pk2(o0[4 * g], o0[4 * g + 1]); w0.y = pk2(o0[4 * g + 2], o0[4 * g + 3]); w1.x = pk2(o1[4 * g], o1[4 * g + 1]); w1.y = pk2(o1[4 * g + 2], o1[4 * g + 3]);
            *(LAS u32x2*)(wl + r * GB_P + (32 * dvt + 8 * g + 4 * h) * 2) = w0; *(LAS u32x2*)(wl + (32 + r) * GB_P + (32 * dvt + 8 * g + 4 * h) * 2) = w1; }
    }
    ss0 += __shfl_xor(ss0, 32); ss1 += __shfl_xor(ss1, 32);
    LAS float* rsv = (LAS float*)(wl + 64 * GB_P);
    if (h == 0) { rsv[r] = rsqrtf(ss0 * (1.f / 128.f) + EPS); rsv[32 + r] = rsqrtf(ss1 * (1.f / 128.f) + EPS); }
    const f32x4 g0 = *(const f32x4*)(ggla + hb * 128 + 8 * (lane & 15)), g1 = *(const f32x4*)(ggla + hb * 128 + 8 * (lane & 15) + 4);
#pragma unroll 4
    for (int k = 0; k < 16; ++k) { const int p = lane + 64 * k, tok = p >> 4, pc = p & 15;
        const u32x4 ow = *(const LAS u32x4*)(wl + tok * GB_P + pc * 16); const float rs = rsv[tok];
        const u32x4 gw = __builtin_nontemporal_load((const u32x4*)(RS + (row0 + tok) * 512 + hb * 128 + 8 * pc));
        u32x4 yo;
        yo.x = pk2(bf2f(ow.x & 0xffffu) * rs * g0[0] * bf2f(gw.x & 0xffffu), bf2f(ow.x >> 16) * rs * g0[1] * bf2f(gw.x >> 16));
        yo.y = pk2(bf2f(ow.y & 0xffffu) * rs * g0[2] * bf2f(gw.y & 0xffffu), bf2f(ow.y >> 16) * rs * g0[3] * bf2f(gw.y >> 16));
        yo.z = pk2(bf2f(ow.z & 0xffffu) * rs * g1[0] * bf2f(gw.z & 0xffffu), bf2f(ow.z >> 16) * rs * g1[1] * bf2f(gw.z >> 16));
        yo.w = pk2(bf2f(ow.w & 0xffffu) * rs * g1[2] * bf2f(gw.w & 0xffffu), bf2f(ow.w >> 16) * rs * g1[3] * bf2f(gw.w >> 16));
        *(u32x4*)(Y + (row0 + tok) * 1024 + 512 + hb * 128 + 8 * pc) = yo; }
}

__device__ __forceinline__ void gla_sample_unit(LAS unsigned char* lds, const float* LA, const bf16_t* QB, const bf16_t* KB, const bf16_t* VB, const bf16_t* RS,
                                                const float* S0, const float* ggla, bf16_t* Y, float* Sout, int b, int hb, int tid) {
    LAS float* q = (LAS float*)lds; LAS float* k = q + 2048; LAS float* a = k + 2048; LAS float* v = a + 2048; LAS float* part = v + 4096; LAS float* O = part + 512;
    const size_t row0 = (size_t)MP + (size_t)b * TS;
#pragma unroll
    for (int i = 0; i < 4; ++i) { const int idx = tid + 512 * i, t = idx >> 6, dk = idx & 63;
        q[idx] = bf2f(QB[(row0 + t) * 256 + hb * 64 + dk]); k[idx] = bf2f(KB[(row0 + t) * 256 + hb * 64 + dk]); a[idx] = __expf(LA[((size_t)b * TS + t) * 256 + hb * 64 + dk]); }
#pragma unroll
    for (int i = 0; i < 8; ++i) { const int idx = tid + 512 * i, t = idx >> 7, dv = idx & 127; v[idx] = bf2f(VB[((size_t)b * TS + t) * 512 + hb * 128 + dv]); }
    const int dv = tid & 127, g = tid >> 7;
    float S[16];
    const float* s0 = S0 + (size_t)(b * 4 + hb) * 8192;
#pragma unroll
    for (int i = 0; i < 16; ++i) S[i] = s0[(16 * g + i) * 128 + dv];
    __syncthreads();
    for (int t = 0; t < TS; ++t) {
        const float vv = v[t * 128 + dv]; float p = 0.f;
#pragma unroll
        for (int i = 0; i < 16; ++i) { const int dk = 16 * g + i; S[i] = a[t * 64 + dk] * S[i] + k[t * 64 + dk] * vv; p += q[t * 64 + dk] * S[i]; }
        part[g * 128 + dv] = p;
        __syncthreads();
        if (tid < 128) O[t * 128 + tid] = (part[tid] + part[128 + tid]) + (part[256 + tid] + part[384 + tid]);
        __syncthreads();
    }
    float* so = Sout + (size_t)(b * 4 + hb) * 8192;
#pragma unroll
    for (int i = 0; i < 16; ++i) so[(16 * g + i) * 128 + dv] = S[i];
    { const int lane = tid & 63, wave = tid >> 6;
#pragma unroll
      for (int tt = 0; tt < 4; ++tt) { const int t = 4 * wave + tt; const float o0 = O[t * 128 + lane], o1 = O[t * 128 + 64 + lane];
          const float rs = rsqrtf(wave_sum(o0 * o0 + o1 * o1) * (1.f / 128.f) + EPS);
          Y[(row0 + t) * 1024 + 512 + hb * 128 + lane] = f2bf(o0 * rs * ggla[hb * 128 + lane] * bf2f(RS[(row0 + t) * 512 + hb * 128 + lane]));
          Y[(row0 + t) * 1024 + 512 + hb * 128 + 64 + lane] = f2bf(o1 * rs * ggla[hb * 128 + 64 + lane] * bf2f(RS[(row0 + t) * 512 + hb * 128 + 64 + lane])); } }
    __syncthreads();
}


constexpr int MA_QP = 528, MA_QS1 = 16896, MA_PS = 33792, MA_MX = 50688, MA_SUM = 51712, MA_OS = 52736;
__device__ __forceinline__ void mem_attn_item(LAS unsigned char* lds, const bf16_t* Kh, const bf16_t* VTh, const bf16_t* Qh, bf16_t* Oh, int ntiles, int tid) {
    const int lane = tid & 63, wave = tid >> 6, r = lane & 31, h = lane >> 5;
    LAS unsigned char* Ps = lds + MA_PS; LAS float* MX = (LAS float*)(lds + MA_MX); LAS float* SUM = (LAS float*)(lds + MA_SUM);
    bf16x8 kf[16], vf[16];
#pragma unroll
    for (int s = 0; s < 16; ++s) kf[s] = *(const bf16x8*)(Kh + (size_t)(32 * wave + r) * 1024 + 16 * s + 8 * h);
#pragma unroll
    for (int s = 0; s < 16; ++s) vf[s] = *(const bf16x8*)(VTh + (size_t)(32 * wave + r) * 256 + 16 * s + 8 * h);
    const int q0 = tid >> 5, c0 = tid & 31;
    u32x4 qreg[2];
    qreg[0] = *(const u32x4*)(Qh + (size_t)q0 * 1024 + 8 * c0); qreg[1] = *(const u32x4*)(Qh + (size_t)(q0 + 16) * 1024 + 8 * c0);
    *(LAS u32x4*)(lds + q0 * MA_QP + 16 * c0) = qreg[0]; *(LAS u32x4*)(lds + (q0 + 16) * MA_QP + 16 * c0) = qreg[1];
    for (int t = 0; t < ntiles; ++t) {
        const LAS unsigned char* cur = lds + ((t & 1) ? MA_QS1 : 0); LAS unsigned char* nxt = lds + ((t & 1) ? 0 : MA_QS1);
        const bool more = t + 1 < ntiles;
        if (more) { const bf16_t* qn = Qh + (size_t)(32 * (t + 1)) * 1024;
            qreg[0] = *(const u32x4*)(qn + (size_t)q0 * 1024 + 8 * c0); qreg[1] = *(const u32x4*)(qn + (size_t)(q0 + 16) * 1024 + 8 * c0); }
        if (t == 0) __syncthreads();
        f32x16 sacc, sacb;
#pragma unroll
        for (int i = 0; i < 16; ++i) { sacc[i] = 0.f; sacb[i] = 0.f; }
#pragma unroll
        for (int s = 0; s < 16; s += 2) {
            sacc = MFMA32(kf[s], *(const LAS bf16x8*)(cur + r * MA_QP + (16 * s + 8 * h) * 2), sacc);
            sacb = MFMA32(kf[s + 1], *(const LAS bf16x8*)(cur + r * MA_QP + (16 * (s + 1) + 8 * h) * 2), sacb); }
#pragma unroll
        for (int i = 0; i < 16; ++i) sacc[i] += sacb[i];
        float mx = sacc[0];
#pragma unroll
        for (int i = 1; i < 16; ++i) mx = fmaxf(mx, sacc[i]);
        mx = fmaxf(mx, __shfl_xor(mx, 32));
        if (h == 0) MX[wave * 32 + r] = mx;
        __syncthreads();
        float m = MX[r];
#pragma unroll
        for (int w = 1; w < 8; ++w) m = fmaxf(m, MX[w * 32 + r]);
        float ps = 0.f;
#pragma unroll
        for (int i = 0; i < 16; ++i) { const float p = __builtin_amdgcn_exp2f(sacc[i] - m); sacc[i] = p; ps += p; }
        ps += __shfl_xor(ps, 32);
        if (h == 0) SUM[wave * 32 + r] = ps;
#pragma unroll
        for (int g = 0; g < 4; ++g) { u32x2 w2; w2.x = pk2(sacc[4 * g], sacc[4 * g + 1]); w2.y = pk2(sacc[4 * g + 2], sacc[4 * g + 3]);
            *(LAS u32x2*)(Ps + r * MA_QP + (32 * wave + 8 * g + 4 * h) * 2) = w2; }
        if (more) { *(LAS u32x4*)(nxt + q0 * MA_QP + 16 * c0) = qreg[0]; *(LAS u32x4*)(nxt + (q0 + 16) * MA_QP + 16 * c0) = qreg[1]; }
        if (t > 0) {
            bf16_t* op = Oh + (size_t)(32 * (t - 1)) * 1024;
            *(u32x4*)(op + (size_t)q0 * 1024 + 8 * c0) = *(const LAS u32x4*)(lds + MA_OS + q0 * MA_QP + 16 * c0);
            *(u32x4*)(op + (size_t)(q0 + 16) * 1024 + 8 * c0) = *(const LAS u32x4*)(lds + MA_OS + (q0 + 16) * MA_QP + 16 * c0); }
        __syncthreads();
        f32x16 o, ob;
#pragma unroll
        for (int i = 0; i < 16; ++i) { o[i] = 0.f; ob[i] = 0.f; }
#pragma unroll
        for (int s = 0; s < 16; s += 2) {
            o = MFMA32(vf[s], *(const LAS bf16x8*)(Ps + r * MA_QP + (16 * s + 8 * h) * 2), o);
            ob = MFMA32(vf[s + 1], *(const LAS bf16x8*)(Ps + r * MA_QP + (16 * (s + 1) + 8 * h) * 2), ob); }
#pragma unroll
        for (int i = 0; i < 16; ++i) o[i] += ob[i];
        float l = SUM[r];
#pragma unroll
        for (int w = 1; w < 8; ++w) l += SUM[w * 32 + r];
        const float inv = 1.f / l;
#pragma unroll
        for (int g = 0; g < 4; ++g) { u32x2 w2; w2.x = pk2(o[4 * g] * inv, o[4 * g + 1] * inv); w2.y = pk2(o[4 * g + 2] * inv, o[4 * g + 3] * inv);
            *(LAS u32x2*)(lds + MA_OS + r * MA_QP + (32 * wave + 8 * g + 4 * h) * 2) = w2; }
    }
    __syncthreads();
    { bf16_t* op = Oh + (size_t)(32 * (ntiles - 1)) * 1024;
      *(u32x4*)(op + (size_t)q0 * 1024 + 8 * c0) = *(const LAS u32x4*)(lds + MA_OS + q0 * MA_QP + 16 * c0);
      *(u32x4*)(op + (size_t)(q0 + 16) * 1024 + 8 * c0) = *(const LAS u32x4*)(lds + MA_OS + (q0 + 16) * MA_QP + 16 * c0); }
    __syncthreads();
}

__device__ __forceinline__ void small_gemm(LAS unsigned char* lds, const bf16_t* A, const bf16_t* Bt, bf16_t* O, int K, float scale, int bx, int G, int tid) {
    LAS float* red = (LAS float*)lds;
    const int lane = tid & 63, wave = tid >> 6, r = lane & 31, h = lane >> 5;
    const int kw = K / 8, nch = kw / 32;
    LAS unsigned char* sl = lds + 65536 + wave * 7680;
    const int lr = lane >> 2, lp = lane & 3;
    for (int tile = bx; tile < 256; tile += G) {
        const int row0 = (tile >> 5) * 64, col0 = (tile & 31) * 32;
        const bf16_t* ap = A + (size_t)(row0 + lr) * K + wave * kw + 8 * lp;
        const bf16_t* bp = Bt + (size_t)(col0 + lr) * K + wave * kw + 8 * lp;
        u32x4 ar[4], br[2];
#pragma unroll
        for (int i = 0; i < 4; ++i) ar[i] = *(const u32x4*)(ap + (size_t)(16 * i) * K);
#pragma unroll
        for (int i = 0; i < 2; ++i) br[i] = *(const u32x4*)(bp + (size_t)(16 * i) * K);
        f32x16 acc0, acc1;
#pragma unroll
        for (int i = 0; i < 16; ++i) { acc0[i] = 0.f; acc1[i] = 0.f; }
        for (int ch = 0; ch < nch; ++ch) {
#pragma unroll
            for (int i = 0; i < 4; ++i) *(LAS u32x4*)(sl + (lr + 16 * i) * 80 + 16 * lp) = ar[i];
#pragma unroll
            for (int i = 0; i < 2; ++i) *(LAS u32x4*)(sl + 5120 + (lr + 16 * i) * 80 + 16 * lp) = br[i];
            if (ch + 1 < nch) {
#pragma unroll
                for (int i = 0; i < 4; ++i) ar[i] = *(const u32x4*)(ap + (size_t)(16 * i) * K + 32 * (ch + 1));
#pragma unroll
                for (int i = 0; i < 2; ++i) br[i] = *(const u32x4*)(bp + (size_t)(16 * i) * K + 32 * (ch + 1));
            }
#pragma unroll
            for (int ks = 0; ks < 2; ++ks) {
                const bf16x8 fb = *(const LAS bf16x8*)(sl + 5120 + r * 80 + (16 * ks + 8 * h) * 2);
                acc0 = MFMA32(*(const LAS bf16x8*)(sl + r * 80 + (16 * ks + 8 * h) * 2), fb, acc0);
                acc1 = MFMA32(*(const LAS bf16x8*)(sl + (32 + r) * 80 + (16 * ks + 8 * h) * 2), fb, acc1);
            }
        }
#pragma unroll
        for (int i = 0; i < 16; ++i) { red[((wave * 2 + 0) * 16 + i) * 64 + lane] = acc0[i]; red[((wave * 2 + 1) * 16 + i) * 64 + lane] = acc1[i]; }
        __syncthreads();
#pragma unroll
        for (int j = 0; j < 4; ++j) { const int e = tid + 512 * j, le = e & 63, ie = (e >> 6) & 15, mh = e >> 10; float sum = 0.f;
#pragma unroll
            for (int w = 0; w < 8; ++w) sum += red[((w * 2 + mh) * 16 + ie) * 64 + le];
            O[(size_t)(row0 + 32 * mh + crow(ie, le >> 5)) * 1024 + col0 + (le & 31)] = f2bf(sum * scale); }
        __syncthreads();
    }
}
#define XB_TMO      128
#define XB_XCNT(j)  (256  + 64 * (j))
#define XB_XSUB(j)  (1280 + 64 * (j))
#define XB_XGEN(j)  (2304 + 64 * (j))
#define XB_TOP      3328
#define XB_TOPGEN   3392
#define XCD_BAR_WORDS 3456
#define XB_SPIN_CAP (1u << 18)

__device__ __forceinline__ unsigned xb_ld(unsigned* p)              { return __hip_atomic_load(p, __ATOMIC_RELAXED, __HIP_MEMORY_SCOPE_AGENT); }
__device__ __forceinline__ unsigned xb_add(unsigned* p, unsigned v) { return __hip_atomic_fetch_add(p, v, __ATOMIC_RELAXED, __HIP_MEMORY_SCOPE_AGENT); }
__device__ __forceinline__ unsigned xb_xcc_id() { return (unsigned)__builtin_amdgcn_s_getreg((3 << 11) | 20) & 0xFu; }
#define XB_SPIN(cond, bar) do { unsigned _sp = 0; while (cond) { __builtin_amdgcn_s_sleep(1); \
    if ((++_sp & 255u) == 0u) { if (xb_ld(&(bar)[XB_TMO])) break; if (_sp > XB_SPIN_CAP) { atomicAdd(&(bar)[XB_TMO], 1u); break; } } } } while (0)

struct XcdBarrier {
    unsigned* bar; unsigned x;
    volatile LAS unsigned* st;
};

__device__ __forceinline__ XcdBarrier xcd_barrier_post(unsigned* bar, volatile LAS unsigned* st) {
    XcdBarrier b; b.bar = bar; b.x = xb_xcc_id(); b.st = st;
    if (threadIdx.x == 0) (void)xb_add(&bar[XB_XCNT(b.x)], 1u);
    return b;
}
__device__ __forceinline__ void xcd_barrier_complete(unsigned* bar, unsigned x, unsigned& nloc, unsigned& nx) {
    const unsigned G = gridDim.x * gridDim.y * gridDim.z;
    unsigned sum, cnt, mine, sp = 0u;
    for (;;) {
        sum = 0u; cnt = 0u; mine = 0u;
#pragma unroll
        for (unsigned j = 0; j < 16; ++j) { const unsigned c = xb_ld(&bar[XB_XCNT(j)]); sum += c; cnt += (c > 0u) ? 1u : 0u; mine = (j == x) ? c : mine; }
        if (sum == G) break;
        __builtin_amdgcn_s_sleep(1);
        if ((++sp & 255u) == 0u) { if (xb_ld(&bar[XB_TMO])) break; if (sp > XB_SPIN_CAP) { atomicAdd(&bar[XB_TMO], 1u); break; } }
    }
    nloc = mine > 0u ? mine : 1u; nx = cnt > 0u ? cnt : 1u;
}

__device__ __forceinline__ void xcd_barrier(const XcdBarrier& b) {
    asm volatile("s_waitcnt vmcnt(0)" ::: "memory");
    __syncthreads();
    if (threadIdx.x == 0) {
        unsigned* bar = b.bar;
        __builtin_amdgcn_s_waitcnt(0);
        unsigned nloc = b.st[0], nx = b.st[1];
        if (nloc == 0u) { xcd_barrier_complete(bar, b.x, nloc, nx); b.st[0] = nloc; b.st[1] = nx; }
        const unsigned old = xb_add(&bar[XB_XSUB(b.x)], 1u);
        const unsigned gen = old / nloc;
        if (old + 1u == (gen + 1u) * nloc) {
            __builtin_amdgcn_fence(__ATOMIC_RELEASE, "agent");
            asm volatile("s_waitcnt vmcnt(0)" ::: "memory");
            const unsigned og = xb_add(&bar[XB_TOP], 1u);
            const unsigned tg = og / nx;
            if (og + 1u == (tg + 1u) * nx) xb_add(&bar[XB_TOPGEN], 1u);
            else XB_SPIN(xb_ld(&bar[XB_TOPGEN]) == tg, bar);
            __builtin_amdgcn_fence(__ATOMIC_ACQUIRE, "agent");
            xb_add(&bar[XB_XGEN(b.x)], 1u);
            asm volatile("s_waitcnt vmcnt(0)" ::: "memory");
        } else {
            XB_SPIN(xb_ld(&bar[XB_XGEN(b.x)]) == gen, bar);
            __builtin_amdgcn_fence(__ATOMIC_ACQUIRE, "agent");
            asm volatile("s_waitcnt vmcnt(0)" ::: "memory");
        }
    }
    __syncthreads();
}

#ifndef PHMASK
#define PHMASK 0xFFFF
#endif
#define PH(n) (((PHMASK) >> (n)) & 1)
#ifndef DBLMASK
#define DBLMASK 0
#endif
#define NREP(n) ((((DBLMASK) >> (n)) & 1) ? 2 : 1)
__global__ void __launch_bounds__(NTHREADS) fwd_megakernel(Params P) {
    extern __shared__ __attribute__((aligned(16))) unsigned char lds_raw[];
    LAS unsigned char* lds = (LAS unsigned char*)lds_raw;
    cg::grid_group grid = cg::this_grid();
    volatile LAS unsigned* bst = (volatile LAS unsigned*)(lds + LDS_BYTES - 64);
    if (threadIdx.x < 2) bst[threadIdx.x] = 0u;
    __syncthreads();
    const XcdBarrier xbar = xcd_barrier_post((unsigned*)(P.ws + 16384), bst);
#define GRID_BAR() xcd_barrier(xbar)
    if (P.ws == nullptr) grid.sync();
    const int G = gridDim.x, bx = blockIdx.x;
    const int NGW = G * NWAVES, NGT = G * NTHREADS;
#define LOCALS int tid = threadIdx.x; asm volatile("" : "+v"(tid)); const int lane = tid & 63, wave = __builtin_amdgcn_readfirstlane(tid >> 6); \
    const int gw = bx * NWAVES + wave, gt = bx * NTHREADS + tid; (void)lane; (void)gw; (void)gt;
#define WSPTRS __attribute__((address_space(1))) unsigned char* wsg_ = (__attribute__((address_space(1))) unsigned char*)P.ws; asm volatile("" : "+s"(wsg_)); unsigned char* ws = (unsigned char*)wsg_; __attribute__((address_space(1))) float* outg_ = (__attribute__((address_space(1))) float*)P.out; asm volatile("" : "+s"(outg_)); float* out = (float*)outg_; bf16_t* WinT = (bf16_t*)(ws + WS_WIN); bf16_t* WoT = (bf16_t*)(ws + WS_WO); bf16_t* WmqT = (bf16_t*)(ws + WS_WMQ); bf16_t* WmkvT = (bf16_t*)(ws + WS_WMKV); bf16_t* WmoT = (bf16_t*)(ws + WS_WMO); bf16_t* WguT = (bf16_t*)(ws + WS_WGU); bf16_t* WdT = (bf16_t*)(ws + WS_WD); bf16_t* MN = (bf16_t*)(ws + WS_MN); bf16_t* KMP = (bf16_t*)(ws + WS_KMP); bf16_t* VMTP = (bf16_t*)(ws + WS_VMTP); bf16_t* KMS = (bf16_t*)(ws + WS_KMS); bf16_t* VMTS = (bf16_t*)(ws + WS_VMTS); bf16_t* H = (bf16_t*)(ws + WS_H); bf16_t* Y = (bf16_t*)(ws + WS_Y); bf16_t* U = (bf16_t*)(ws + WS_U); float* DS = (float*)(ws + WS_DS); float* DEC = (float*)(ws + WS_DEC); bf16_t* QA = (bf16_t*)(ws + WS_QA); bf16_t* KP = (bf16_t*)(ws + WS_KP); bf16_t* VPT = (bf16_t*)(ws + WS_VPT); bf16_t* KS = (bf16_t*)(ws + WS_KS); bf16_t* VST = (bf16_t*)(ws + WS_VST); bf16_t* QB = (bf16_t*)(ws + WS_QB); bf16_t* KB = (bf16_t*)(ws + WS_KB); bf16_t* VB = (bf16_t*)(ws + WS_VB); bf16_t* RS = (bf16_t*)(ws + WS_RS); float* LA = (float*)(ws + WS_LA); bf16_t* HID = (bf16_t*)(ws + WS_HID); bf16_t* X1 = (bf16_t*)(ws + WS_R); bf16_t* X2 = (bf16_t*)(ws + WS_Y); bf16_t* KBT = (bf16_t*)(ws + WS_KBT); bf16_t* VBS = (bf16_t*)(ws + WS_VBS); float* LAS_ = (float*)(ws + WS_LAS); float* BC = (float*)(ws + WS_BC); bf16_t* SST = (bf16_t*)(ws + WS_SST); bf16_t* BT1 = (bf16_t*)(ws + WS_BT1); bf16_t* BT2 = (bf16_t*)(ws + WS_BT2); bf16_t* WMQN = (bf16_t*)(ws + WS_WMQN); bf16_t* VMN = (bf16_t*)(ws + WS_VMN);
    for (int rep_ = 0; rep_ < NREP(0); ++rep_) {
    if constexpr (PH(0)) { WSPTRS
        LOCALS
        LAS float* scr = (LAS float*)(lds + wave * 16384);
        constexpr int C1 = 16 * 80, C2 = 16 * 16, C3 = 16 * 32, C8 = 16 * 88, C10 = 44 * 32, C11 = 128 * 16, C12 = 64 * 32;
        constexpr int NITEMS = C1 + C2 + 5 * C3 + 2 * C8 + C10 + C11 + C12;
        for (int it = gw; it < NITEMS; it += NGW) {
            int r = it;
            if (r < C1) { tr_item(P.in[I_WIN], 3088, WinT, 1024, 64 * (r / 80), 32 * (r % 80), 32 * (r % 80), scr, lane); continue; } r -= C1;
            if (r < C2) { tr_item(P.in[I_WIN] + 2576, 3088, WinT, 1024, 64 * (r / 16), 32 * (r % 16), 2560 + 32 * (r % 16), scr, lane); continue; } r -= C2;
            if (r < C3) { tr_item(P.in[I_WO], 1024, WoT, 1024, 64 * (r / 32), 32 * (r % 32), 32 * (r % 32), scr, lane); continue; } r -= C3;
            if (r < C3) { tr_item(P.in[I_WMQ], 1024, WmqT, 1024, 64 * (r / 32), 32 * (r % 32), 32 * (r % 32), scr, lane); continue; } r -= C3;
            if (r < C3) { tr_item(P.in[I_WMK], 1024, WmkvT, 1024, 64 * (r / 32), 32 * (r % 32), 32 * (r % 32), scr, lane); continue; } r -= C3;
            if (r < C3) { tr_item(P.in[I_WMV], 1024, WmkvT, 1024, 64 * (r / 32), 32 * (r % 32), 1024 + 32 * (r % 32), scr, lane); continue; } r -= C3;
            if (r < C3) { tr_item(P.in[I_WMO], 1024, WmoT, 1024, 64 * (r / 32), 32 * (r % 32), 32 * (r % 32), scr, lane); continue; } r -= C3;
            if (r < C8) { const int n0 = 32 * (r % 88); tr_item(P.in[I_WG], DFF, WguT, 1024, 64 * (r / 88), n0, (n0 >> 7) * 256 + (n0 & 127), scr, lane); continue; } r -= C8;
            if (r < C8) { const int n0 = 32 * (r % 88); tr_item(P.in[I_WU], DFF, WguT, 1024, 64 * (r / 88), n0, (n0 >> 7) * 256 + 128 + (n0 & 127), scr, lane); continue; } r -= C8;
            if (r < C10) { tr_item(P.in[I_WDN], 1024, WdT, DFF, 64 * (r / 32), 32 * (r % 32), 32 * (r % 32), scr, lane); continue; } r -= C10;
            if (r < C11) { const int bh = r >> 4, q = r & 15, b = bh >> 3, hh = bh & 7;
                tr_item(P.in[I_CAV] + (size_t)b * 512 * 512 + hh * 64, 512, VST + (size_t)bh * 64 * 544, 544, 64 * (q >> 1), 32 * (q & 1), 32 * (q & 1), scr, lane); continue; } r -= C11;
            { const int bh = r >> 5, q = r & 31, b = bh >> 2, hh = bh & 3;
                tr_item(P.in[I_CMV] + (size_t)b * 256 * 1024 + hh * 256, 1024, VMTS + (size_t)bh * 256 * 256, 256, 64 * (q >> 3), 32 * (q & 7), 32 * (q & 7), scr, lane); }
        }
        for (int idx = gt; idx < 256 * 1024; idx += NGT) { const int n = idx >> 10, k = idx & 1023; const float* wr_ = P.in[I_WIN] + (size_t)k * 3088 + 2560; const float* a2 = P.in[I_WA2] + n;
            float s = 0.f;
#pragma unroll
            for (int q4 = 0; q4 < 4; ++q4) { const f32x4 w4 = *(const f32x4*)(wr_ + 4 * q4);
                s += (w4[0] * a2[(4 * q4) * 256] + w4[1] * a2[(4 * q4 + 1) * 256]) + (w4[2] * a2[(4 * q4 + 2) * 256] + w4[3] * a2[(4 * q4 + 3) * 256]); }
            WinT[(size_t)(3072 + n) * 1024 + k] = f2bf(s); }
        for (int idx = gt; idx < 1024 * 1024 / 4; idx += NGT) st_bf4(WMQN + (size_t)idx * 4, *(const f32x4*)(P.in[I_WMQ] + (size_t)idx * 4));
        for (int idx = gt; idx < NBS * 512 * 512 / 4; idx += NGT) { const int e = idx * 4, b = e >> 18, rem = e & 262143, t = rem >> 9, c = rem & 511;
            st_bf4(KS + ((size_t)b * 544 + t) * 512 + c, __builtin_nontemporal_load((const f32x4*)(P.in[I_CAK] + e))); }
        for (int idx = gt; idx < NBS * 256 * 1024 / 4; idx += NGT) st_bf4(KMS + (size_t)idx * 4, __builtin_nontemporal_load((const f32x4*)(P.in[I_CMK] + (size_t)idx * 4)));
        f32x4 gmix[2][2], gmem[2][2];
#pragma unroll
        for (int j = 0; j < 2; ++j)
#pragma unroll
            for (int hf = 0; hf < 2; ++hf) { gmix[j][hf] = *(const f32x4*)(P.in[I_GPREMIX] + 512 * j + 8 * lane + 4 * hf); gmem[j][hf] = *(const f32x4*)(P.in[I_GMEM] + 512 * j + 8 * lane + 4 * hf); }
        { int m = gw;
          for (; m + 3 * NGW < MT; m += 4 * NGW) {
              const float* const xr[4] = {xrow_ptr(P.in[I_XP], P.in[I_XS], m), xrow_ptr(P.in[I_XP], P.in[I_XS], m + NGW), xrow_ptr(P.in[I_XP], P.in[I_XS], m + 2 * NGW), xrow_ptr(P.in[I_XP], P.in[I_XS], m + 3 * NGW)};
              bf16_t* const orw[4] = {H + (size_t)m * DM, H + (size_t)(m + NGW) * DM, H + (size_t)(m + 2 * NGW) * DM, H + (size_t)(m + 3 * NGW) * DM};
              rms_rows_bf16<4>(xr, gmix, orw, lane); }
          for (; m < MT; m += NGW) { const float* const xr[1] = {xrow_ptr(P.in[I_XP], P.in[I_XS], m)}; bf16_t* const orw[1] = {H + (size_t)m * DM}; rms_rows_bf16<1>(xr, gmix, orw, lane); } }
        for (int m = gw; m < 512; m += NGW) { const float* const xr[1] = {P.in[I_MEM] + (size_t)m * DM}; bf16_t* const orw[1] = {MN + (size_t)m * DM}; rms_rows_bf16<1>(xr, gmem, orw, lane); }
    }
    GRID_BAR();
    }

    for (int rep_ = 0; rep_ < NREP(1); ++rep_) {
    if constexpr (PH(1)) { WSPTRS
        pg8::Gemm g{H, WinT, MT, NIN, DM}; pg8::StaticOrder S; S.init(MT, NIN, G, bx);
        EpiIn E{ws, P.in[I_BA], out, lds + EPT_OFF};
        pg8::gemm_phase<EpiIn, pg8::StaticOrder, true, true>(lds, g, S, E);
        pg8::Gemm g2{MN, WmkvT, 512, 2048, DM}; pg8::StaticOrder S2; S2.init(512, 2048, G, (bx + 16) % G);
        EpiMem E2{KMP, VMTP, VMN, out};
        pg8::gemm_phase<EpiMem, pg8::StaticOrder, true, true>(lds, g2, S2, E2);
    }
    GRID_BAR();
    }

    if constexpr (PH(2)) { WSPTRS
        LOCALS
        LAS float* rtab = (LAS float*)lds;
        for (int i = tid; i < 8 * 640; i += NTHREADS) { const int hh = i / 640, x = i - hh * 640; int d = 576 - x; d = d < -256 ? -256 : (d > 256 ? 256 : d);
            rtab[i] = P.in[I_RELB][hh * 513 + d + 256] * LOG2E; }
        __syncthreads();
        const LAS float* rv = rtab + wave * 640; LAS unsigned char* wl = lds + BA_TAB + wave * BA_WAVE;
        for (int rep_ = 0; rep_ < NREP(2); ++rep_)
        for (int k = bx >> 3; k < 64; k += (G >> 3)) {
            const int u = (bx & 7) * 64 + k; const int b = u >> 8, nc = u & 255; const int j0 = (nc < 8 ? (8 - nc) : 0) * 64;
            const long kbase = (long)b * SEQ + (long)(nc - 8) * 64; const size_t qrow = (size_t)b * SEQ + nc * 64;
            band_core64(QA + qrow * 512 + wave * 64, KP + kbase * 512 + wave * 64, 512, VPT + ((long)(b * 8 + wave) * 64) * SEQ + (long)(nc - 8) * 64, SEQ, j0, 576,
                        rv, Y + qrow * 1024 + wave * 64, wl, lane);
        }
        __syncthreads();
        for (int rep_ = 0; rep_ < NREP(14); ++rep_)
        for (int u = gw; u < NBP * NCH * 4; u += NGW) gla_wave_a(lds + wave * GA_WAVE, LA, KBT, VB, BC, DS, DEC, u, lane);
    }
    GRID_BAR();

    for (int rep_ = 0; rep_ < NREP(3); ++rep_) {
    if constexpr (PH(3)) { WSPTRS LOCALS
      if (bx < 128) {
        const int g = bx * 512 + tid;
        if (g < 8 * 8192) { const int seq = g >> 13, e = g & 8191, dk = e & 63, dv = e >> 6; float S = 0.f;
            const float* ds = DS + (size_t)seq * NCH * 8192 + e; const float* dc = DEC + (size_t)seq * NCH * 64 + dk; bf16_t* st = SST + (size_t)seq * NCH * 8192 + e;
            for (int c0 = 0; c0 < NCH; c0 += 32) { float dvv[32], de[32];
#pragma unroll
                for (int i = 0; i < 32; ++i) { dvv[i] = __builtin_nontemporal_load(ds + (size_t)(c0 + i) * 8192); de[i] = dc[(c0 + i) * 64]; }
#pragma unroll
                for (int i = 0; i < 32; ++i) { st[(size_t)(c0 + i) * 8192] = f2bf(S); S = de[i] * S + dvv[i]; } }
            out[OUT_PGLA + (size_t)seq * 8192 + dk * 128 + dv] = S; }

      } else if (bx < 128 + NBS) {
        LAS float* rtab = (LAS float*)lds;
        for (int i = tid; i < 8 * 640; i += NTHREADS) { const int hh = i / 640, x = i - hh * 640; int d = 576 - x; d = d < -256 ? -256 : (d > 256 ? 256 : d);
            rtab[i] = P.in[I_RELB][hh * 513 + d + 256] * LOG2E; }
        __syncthreads();
        const int b = bx - 128; const size_t qrow = (size_t)MP + b * TS;
        band_core(QA + qrow * 512 + wave * 64, KS + (size_t)b * 544 * 512 + wave * 64, 512, VST + ((size_t)(b * 8 + wave) * 64) * 544, 544, 0, 544,
                  rtab + wave * 640, 512, Y + qrow * 1024 + wave * 64, lds + BA_TAB + wave * BA_WAVE, lane);
      } else if (bx >= G - 64) { const int u = G - 1 - bx; gla_sample_unit(lds, LAS_, QB, KB, VBS, RS, P.in[I_SGLA], P.in[I_GGLA], Y, out + OUT_SGLA, u >> 2, u & 3, tid); }
    }
    GRID_BAR();
    }

    for (int rep_ = 0; rep_ < NREP(4); ++rep_) {
    if constexpr (PH(4)) { WSPTRS LOCALS for (int u = gw; u < NBP * NCH * 4; u += NGW) gla_wave_b(lds + wave * GB_WAVE, BC, QB, KB, VB, SST, RS, P.in[I_GGLA], Y, u, lane);
        for (int t = gw; t < 4096; t += NGW) { const int job = t >> 11, tt = t & 2047, nh = tt >> 8, n = nh >> 2, hh = nh & 3, ti = tt & 255;
            if (job == 0) { const int kt = ti >> 5, ct = ti & 31;
                pre_tile(KMP + ((size_t)n * 256 + 32 * kt) * 1024 + hh * 256, 1024, WMQN + (size_t)(32 * ct) * 1024 + hh * 256, 1024, BT1 + ((size_t)(n * 4 + hh) * 256 + 32 * kt) * 1024 + 32 * ct, 1024, 0.0625f * LOG2E, lane); }
            else { const int ct = ti >> 3, kt = ti & 7;
                pre_tile(WmoT + (size_t)(32 * ct) * 1024 + hh * 256, 1024, VMN + ((size_t)n * 256 + 32 * kt) * 1024 + hh * 256, 1024, BT2 + ((size_t)n * 1024 + 32 * ct) * 1024 + hh * 256 + 32 * kt, 1024, 1.f, lane); } }
    }
    GRID_BAR();
    }

    for (int rep_ = 0; rep_ < NREP(5); ++rep_) {
    if constexpr (PH(5)) { WSPTRS pg8::Gemm g{Y, WoT, MP, DM, DM}; pg8::StaticOrder S; S.init(MP, DM, G, bx); EpiPlain E{U, DM, 1.f};
      pg8::gemm_phase<EpiPlain, pg8::StaticOrder, true, true>(lds, g, S, E);
      LOCALS small_gemm(lds, Y + (size_t)MP * DM, WoT, U + (size_t)MP * DM, DM, 1.f, bx, G, tid); }
    GRID_BAR();
    }
    for (int rep_ = 0; rep_ < NREP(6); ++rep_) {
    if constexpr (PH(6)) { WSPTRS LOCALS
        int m = gw; const RowGains RG = load_gains(P.in[I_GPOSTMIX], P.in[I_GPREMEM], lane);
        for (; m + 3 * NGW < MT; m += 4 * NGW) { const bf16_t* const ur[4] = {U + (size_t)(m) * DM, U + (size_t)(m + 1 * NGW) * DM, U + (size_t)(m + 2 * NGW) * DM, U + (size_t)(m + 3 * NGW) * DM}; const void* const xi[4] = {(const void*)xrow_ptr(P.in[I_XP], P.in[I_XS], m), (const void*)xrow_ptr(P.in[I_XP], P.in[I_XS], m + 1 * NGW), (const void*)xrow_ptr(P.in[I_XP], P.in[I_XS], m + 2 * NGW), (const void*)xrow_ptr(P.in[I_XP], P.in[I_XS], m + 3 * NGW)};
            void* const xo[4] = {(void*)(X1 + (size_t)(m) * DM), (void*)(X1 + (size_t)(m + 1 * NGW) * DM), (void*)(X1 + (size_t)(m + 2 * NGW) * DM), (void*)(X1 + (size_t)(m + 3 * NGW) * DM)}; bf16_t* const ho[4] = {H + (size_t)(m) * DM, H + (size_t)(m + 1 * NGW) * DM, H + (size_t)(m + 2 * NGW) * DM, H + (size_t)(m + 3 * NGW) * DM};
            rowpass_rows<4, false, true>(ur, xi, RG, xo, ho, lane); }
        for (; m < MT; m += NGW) { const bf16_t* const ur[1] = {U + (size_t)(m) * DM}; const void* const xi[1] = {(const void*)xrow_ptr(P.in[I_XP], P.in[I_XS], m)}; void* const xo[1] = {(void*)(X1 + (size_t)(m) * DM)}; bf16_t* const ho[1] = {H + (size_t)(m) * DM};
            rowpass_rows<1, false, true>(ur, xi, RG, xo, ho, lane); } }
    GRID_BAR();
    }
    for (int rep_ = 0; rep_ < NREP(7); ++rep_) {
    if constexpr (PH(7)) { WSPTRS pg8::Gemm g{H, BT1, MP, DM, DM}; OrderMem S; S.S.init(MP, DM, G, bx); EpiSoftmax E{U, lds + EPT_OFF};
      pg8::gemm_phase<EpiSoftmax, OrderMem, true, true>(lds, g, S, E);
      LOCALS small_gemm(lds, H + (size_t)MP * DM, WmqT, U + (size_t)MP * DM, DM, 0.0625f * LOG2E, bx, G, tid); }
    GRID_BAR();
    }
    for (int rep_ = 0; rep_ < NREP(8); ++rep_) {
    if constexpr (PH(8)) { WSPTRS LOCALS
        for (int item = bx; item < NBS * 4; item += G) {
            const int b = item >> 2, hh = item & 3; const size_t row0 = (size_t)MP + (size_t)b * TS;
            mem_attn_item(lds, KMS + (size_t)b * 256 * 1024 + hh * 256, VMTS + (size_t)(b * 4 + hh) * 65536, U + row0 * 1024 + hh * 256, Y + row0 * 1024 + hh * 256, 1, tid);
        }
    }
    GRID_BAR();
    }
    for (int rep_ = 0; rep_ < NREP(9); ++rep_) {
    if constexpr (PH(9)) { WSPTRS pg8::Gemm g{U, BT2, MP, DM, DM}; OrderMem S; S.S.init(MP, DM, G, bx); EpiPlainM E{Y};
      pg8::gemm_phase<EpiPlainM, OrderMem, true, true>(lds, g, S, E);
      LOCALS small_gemm(lds, Y + (size_t)MP * DM, WmoT, U + (size_t)MP * DM, DM, 1.f, bx, G, tid); }
    GRID_BAR();
    }
    if constexpr (PH(10)) { WSPTRS LOCALS
        int m = gw; const RowGains RG = load_gains(P.in[I_GPOSTMEM], P.in[I_GPREFFN], lane);
        for (; m + 3 * NGW < MT; m += 4 * NGW) { const bf16_t* const ur[4] = {((m) < MP ? Y : U) + (size_t)(m) * DM, ((m + 1 * NGW) < MP ? Y : U) + (size_t)(m + 1 * NGW) * DM, ((m + 2 * NGW) < MP ? Y : U) + (size_t)(m + 2 * NGW) * DM, ((m + 3 * NGW) < MP ? Y : U) + (size_t)(m + 3 * NGW) * DM}; const void* const xi[4] = {(const void*)(X1 + (size_t)(m) * DM), (const void*)(X1 + (size_t)(m + 1 * NGW) * DM), (const void*)(X1 + (size_t)(m + 2 * NGW) * DM), (const void*)(X1 + (size_t)(m + 3 * NGW) * DM)};
            void* const xo[4] = {(void*)(X2 + (size_t)(m) * DM), (void*)(X2 + (size_t)(m + 1 * NGW) * DM), (void*)(X2 + (size_t)(m + 2 * NGW) * DM), (void*)(X2 + (size_t)(m + 3 * NGW) * DM)}; bf16_t* const ho[4] = {H + (size_t)(m) * DM, H + (size_t)(m + 1 * NGW) * DM, H + (size_t)(m + 2 * NGW) * DM, H + (size_t)(m + 3 * NGW) * DM};
            rowpass_rows<4, true, true>(ur, xi, RG, xo, ho, lane); }
        for (; m < MT; m += NGW) { const bf16_t* const ur[1] = {((m) < MP ? Y : U) + (size_t)(m) * DM}; const void* const xi[1] = {(const void*)(X1 + (size_t)(m) * DM)}; void* const xo[1] = {(void*)(X2 + (size_t)(m) * DM)}; bf16_t* const ho[1] = {H + (size_t)(m) * DM};
            rowpass_rows<1, true, true>(ur, xi, RG, xo, ho, lane); } }
    GRID_BAR();
    for (int rep_ = 0; rep_ < NREP(11); ++rep_) {
    if constexpr (PH(11)) { WSPTRS pg8::Gemm g{H, WguT, MT, 2 * DFF, DM}; pg8::StaticOrder S; S.init(MT, 2 * DFF, G, bx); EpiSwiglu E{HID};
      pg8::gemm_phase<EpiSwiglu, pg8::StaticOrder, true, true>(lds, g, S, E); }
    GRID_BAR();
    }
    for (int rep_ = 0; rep_ < NREP(12); ++rep_) {
    if constexpr (PH(12)) { WSPTRS pg8::Gemm g{HID, WdT, MP, DM, DFF}; pg8::StaticOrder S; S.init(MP, DM, G, bx); EpiPlain E{U, DM, 1.f};
      pg8::gemm_phase<EpiPlain, pg8::StaticOrder, true, true>(lds, g, S, E);
      LOCALS small_gemm(lds, HID + (size_t)MP * DFF, WdT, U + (size_t)MP * DM, DFF, 1.f, bx, G, tid); }
    GRID_BAR();
    }
    if constexpr (PH(13)) { WSPTRS LOCALS
        int m = gw; const RowGains RG = load_gains(P.in[I_GPOSTFFN], (const float*)nullptr, lane);
        for (; m + 3 * NGW < MT; m += 4 * NGW) { const bf16_t* const ur[4] = {U + (size_t)(m) * DM, U + (size_t)(m + 1 * NGW) * DM, U + (size_t)(m + 2 * NGW) * DM, U + (size_t)(m + 3 * NGW) * DM}; const void* const xi[4] = {(const void*)(X2 + (size_t)(m) * DM), (const void*)(X2 + (size_t)(m + 1 * NGW) * DM), (const void*)(X2 + (size_t)(m + 2 * NGW) * DM), (const void*)(X2 + (size_t)(m + 3 * NGW) * DM)};
            void* const xo[4] = {(void*)(out + (size_t)(m) * DM), (void*)(out + (size_t)(m + 1 * NGW) * DM), (void*)(out + (size_t)(m + 2 * NGW) * DM), (void*)(out + (size_t)(m + 3 * NGW) * DM)}; bf16_t* const ho[4] = {H + (size_t)(m) * DM, H + (size_t)(m + 1 * NGW) * DM, H + (size_t)(m + 2 * NGW) * DM, H + (size_t)(m + 3 * NGW) * DM};
            rowpass_rows<4, true, false>(ur, xi, RG, xo, ho, lane); }
        for (; m < MT; m += NGW) { const bf16_t* const ur[1] = {U + (size_t)(m) * DM}; const void* const xi[1] = {(const void*)(X2 + (size_t)(m) * DM)}; void* const xo[1] = {(void*)(out + (size_t)(m) * DM)}; bf16_t* const ho[1] = {H + (size_t)(m) * DM};
            rowpass_rows<1, true, false>(ur, xi, RG, xo, ho, lane); } }
}

extern "C" void kernel_launch(void* const* d_in, const int* in_sizes, int n_in, void* d_out, int out_size, void* d_ws, size_t ws_size, hipStream_t stream) {
    static int grid = 0;
    if (grid == 0) {
        if (n_in != 28 || (size_t)out_size != OUT_TOTAL || ws_size < WS_END) { fprintf(stderr, "kernel_launch: unexpected problem shape (n_in %d, out %d, ws %zu)\n", n_in, out_size, ws_size); grid = -1; return; }
        int dev = 0, cus = 0, per_cu = 0;
        hipGetDevice(&dev); hipDeviceGetAttribute(&cus, hipDeviceAttributeMultiprocessorCount, dev);
        hipFuncSetAttribute((const void*)fwd_megakernel, hipFuncAttributeMaxDynamicSharedMemorySize, LDS_BYTES);
        hipOccupancyMaxActiveBlocksPerMultiprocessor(&per_cu, (const void*)fwd_megakernel, NTHREADS, LDS_BYTES);
        if (per_cu < 1) { fprintf(stderr, "kernel_launch: occupancy query reports %d blocks per CU\n", per_cu); per_cu = 1; }
        grid = cus;
    }
    if (grid < 0) return;
    if (hipMemsetAsync(d_ws, 0, 65536, stream) != hipSuccess) { fprintf(stderr, "kernel_launch: memset of the barrier words failed\n"); return; }
    Params p{};
    for (int i = 0; i < 28; ++i) p.in[i] = (const float*)d_in[i];
    p.out = (float*)d_out; p.ws = (unsigned char*)d_ws;
    void* args[] = {&p};
    hipError_t e = hipLaunchCooperativeKernel((const void*)fwd_megakernel, dim3(grid), dim3(NTHREADS), args, LDS_BYTES, stream);
    if (e != hipSuccess) fprintf(stderr, "cooperative launch failed: %s (grid %d)\n", hipGetErrorString(e), grid);
}
```

```cpp
#include <hip/hip_runtime.h>
#include <hip/hip_cooperative_groups.h>
#include <cstdio>
#include <cstdint>
namespace cg = cooperative_groups;
namespace pg8 {
#define PG8_LAS __attribute__((address_space(3)))
typedef unsigned short bf16_t;
typedef short bf16x8 __attribute__((ext_vector_type(8)));
typedef float f32x4 __attribute__((ext_vector_type(4)));
typedef unsigned u32x4 __attribute__((ext_vector_type(4)));
constexpr int BM = 256, BK = 64, HALF = 128, HTB = HALF * BK * 2  , STAGE_BYTES = 8 * HTB, NXCD = 8, WGM = 8;

__host__ __device__ __forceinline__ int lds_byte(int r, int c) { const int st = (r >> 4) * 2 + (c >> 5), rr = r & 15, cc = c & 31, ob = rr * 64 + cc * 2; return st * 1024 + (ob ^ (((ob >> 9) & 1) << 5)); }
__host__ __device__ __forceinline__ void stage_rc(int b, int& R, int& C) { const int st = b / 1024, sb = b % 1024, swz = sb ^ (((sb >> 9) & 1) << 5); R = (st >> 1) * 16 + swz / 64; C = (st & 1) * 32 + (swz % 64) / 2; }
__host__ __device__ __forceinline__ int perm32(int rho) { const int n = rho >> 4, i = rho & 15; return 8 * (i >> 2) + 4 * n + (i & 3); }

struct Unit { int pm, pn; };
struct Gemm { const bf16_t* A; const bf16_t* Bt; int M, N, K; };

struct StaticOrder {
    int nM, nN, nwg, G, c;
    __host__ __device__ void init(int M, int N, int G_, int c_) { nM = M / BM; nN = N / BM; nwg = nM * nN; G = G_; c = c_; }
    __host__ __device__ bool next(int i, Unit& u) const {
        const long L = (long)i * G + c; if (L >= nwg) return false;
        int wgid = (int)L; { const int q = nwg / NXCD, r = nwg % NXCD, xcd = wgid % NXCD, off = wgid / NXCD; wgid = (xcd < r ? xcd * (q + 1) : r * (q + 1) + (xcd - r) * q) + off; }
        const int nig = WGM * nN, gid = wgid / nig, fm = gid * WGM, gsz = (nM - fm) < WGM ? (nM - fm) : WGM;
        u.pm = fm + ((wgid % nig) % gsz); u.pn = (wgid % nig) / gsz; return true;
    }
    __device__ __forceinline__ void a_ready(const Unit&) const {}
    __device__ __forceinline__ void done(const Unit&) const {}
};

__device__ __forceinline__ unsigned cvt_pk_bf16(float lo, float hi) { unsigned r; asm volatile("v_cvt_pk_bf16_f32 %0, %1, %2" : "=v"(r) : "v"(lo), "v"(hi)); return r; }
template <class Epi, class Sched, bool ALIGN_EPI = false, bool SP2 = false>
__device__ __forceinline__ void gemm_phase(PG8_LAS unsigned char* lds, const Gemm g, const Sched& S, const Epi& E) {
    int tid_ = threadIdx.x; asm volatile("" : "+v"(tid_));
    const int tid = tid_, wid = __builtin_amdgcn_readfirstlane(tid >> 6), lane = tid & 63, wr = wid >> 2, wc = wid & 3, fr = lane & 15, fq = lane >> 4;
    const int K = g.K, nt = K / BK;
    unsigned voffA[2], voffB[2];
#pragma unroll
    for (int i = 0; i < 2; ++i) { int R, C; stage_rc(tid * 16 + i * 8192, R, C); const int Rb = Epi::PERM ? ((R & ~31) + perm32(R & 31)) : R;
        voffA[i] = (unsigned)(R * K + C) * 2u; voffB[i] = (unsigned)(Rb * K + C) * 2u; }
    const size_t kstep = (size_t)(BK * 2);
    const size_t hstep = (size_t)HALF * K * 2;
    const size_t tstep = 2 * hstep;
    const unsigned ldsw = (unsigned)wid * 1024u;
    const int aoff = lds_byte(wr * 64 + fr, fq * 8), boff = lds_byte(wc * 32 + fr, fq * 8);
#define PG8_SA(b, h) (((b) * 2 + (h)) * HTB)
#define PG8_SB(b, h) ((4 + (b) * 2 + (h)) * HTB)
#define PG8_STAGE(bufoff, gbase, voff) do { _Pragma("unroll") for (int _i = 0; _i < 2; ++_i) \
        __builtin_amdgcn_global_load_lds((const unsigned*)((const char*)(gbase) + (voff)[_i]), (PG8_LAS unsigned*)(lds + (bufoff) + ldsw + _i * 8192), 16, 0, 0); } while (0)
#define PG8_LDA(dst, b, h) do { _Pragma("unroll") for (int m = 0; m < 4; ++m) _Pragma("unroll") for (int k = 0; k < 2; ++k) dst[m][k] = *(const PG8_LAS bf16x8*)(lds + PG8_SA(b, h) + aoff + m * 2048 + k * 1024); } while (0)
#define PG8_LDB(dst, b, h) do { _Pragma("unroll") for (int n = 0; n < 2; ++n) _Pragma("unroll") for (int k = 0; k < 2; ++k) dst[n][k] = *(const PG8_LAS bf16x8*)(lds + PG8_SB(b, h) + boff + n * 2048 + k * 1024); } while (0)
#define PG8_MMA(ai, bj, At, Bt) do { __builtin_amdgcn_s_setprio(1); _Pragma("unroll") for (int m = 0; m < 4; ++m) _Pragma("unroll") for (int n = 0; n < 2; ++n) _Pragma("unroll") for (int k = 0; k < 2; ++k) \
        acc[ai][bj][m][n] = __builtin_amdgcn_mfma_f32_16x16x32_bf16(Bt[n][k], At[m][k], acc[ai][bj][m][n], 0, 0, 0); __builtin_amdgcn_s_setprio(0); } while (0)
#define PG8_WAIT_V(n) asm volatile("s_waitcnt vmcnt(" #n ")" ::: "memory")
#define PG8_WAIT_L(n) asm volatile("s_waitcnt lgkmcnt(" #n ")" ::: "memory")
#define PG8_BAR __builtin_amdgcn_s_barrier()
#define PG8_SCHED __builtin_amdgcn_sched_barrier(0)
    Unit cur, nxt; int ui = 0;
    if (!S.next(0, cur)) return;
    f32x4 acc[2][2][4][2];
#pragma unroll
    for (int a = 0; a < 2; ++a)
#pragma unroll
        for (int b = 0; b < 2; ++b)
#pragma unroll
            for (int m = 0; m < 4; ++m)
#pragma unroll
                for (int n = 0; n < 2; ++n) acc[a][b][m][n] = (f32x4){0.f, 0.f, 0.f, 0.f};
    bf16x8 At[4][2], B0[2][2], B1[2][2];
    const char* cA = (const char*)g.A + (size_t)cur.pm * tstep; const char* cB = (const char*)g.Bt + (size_t)cur.pn * tstep;
    S.a_ready(cur);
    if constexpr (SP2) {
        PG8_STAGE(PG8_SB(0, 0), cB, voffB); PG8_STAGE(PG8_SB(0, 1), cB + hstep, voffB); PG8_STAGE(PG8_SA(0, 0), cA, voffA); PG8_STAGE(PG8_SA(0, 1), cA + hstep, voffA);
        if (wr == 1) PG8_BAR;
        PG8_WAIT_V(2); PG8_BAR;
        PG8_STAGE(PG8_SB(1, 0), cB + kstep, voffB); PG8_STAGE(PG8_SA(1, 0), cA + kstep, voffA); PG8_STAGE(PG8_SB(1, 1), cB + hstep + kstep, voffB);
        PG8_WAIT_V(6); PG8_BAR;
    } else {
        PG8_STAGE(PG8_SB(0, 0), cB, voffB); PG8_STAGE(PG8_SA(0, 0), cA, voffA); PG8_STAGE(PG8_SB(0, 1), cB + hstep, voffB); PG8_STAGE(PG8_SA(0, 1), cA + hstep, voffA);
        if (wr == 1) PG8_BAR;
        PG8_WAIT_V(4); PG8_BAR;
        PG8_STAGE(PG8_SB(1, 0), cB + kstep, voffB); PG8_STAGE(PG8_SA(1, 0), cA + kstep, voffA); PG8_STAGE(PG8_SB(1, 1), cB + hstep + kstep, voffB);
        PG8_WAIT_V(6); PG8_BAR;
    }
    for (;;) {
        const bool has_next = S.next(ui + 1, nxt);
        const char* nA = has_next ? (const char*)g.A + (size_t)nxt.pm * tstep : cA; const char* nB = has_next ? (const char*)g.Bt + (size_t)nxt.pn * tstep : cB;
        for (int t = 0; t < nt; t += 2) {
            const bool last = (t == nt - 2);
            const char* a1 = cA + (size_t)(t + 1) * kstep;
            const char* a2 = last ? nA : cA + (size_t)(t + 2) * kstep; const char* b2 = last ? nB : cB + (size_t)(t + 2) * kstep;
            const char* a3 = a2 + kstep; const char* b3 = b2 + kstep;
            if (last && has_next) S.a_ready(nxt);
            if constexpr (SP2) {
            PG8_LDB(B0, 0, 0); PG8_LDB(B1, 0, 1); PG8_SCHED; PG8_LDA(At, 0, 0); PG8_STAGE(PG8_SA(1, 1), a1 + hstep, voffA);
            PG8_WAIT_V(8); PG8_WAIT_L(0); PG8_BAR; PG8_MMA(0, 0, At, B0); PG8_MMA(0, 1, At, B1); PG8_BAR; PG8_SCHED;
            PG8_LDA(At, 0, 1); PG8_STAGE(PG8_SB(0, 0), b2, voffB); PG8_STAGE(PG8_SB(0, 1), b2 + hstep, voffB); PG8_STAGE(PG8_SA(0, 0), a2, voffA);
            PG8_WAIT_V(8); PG8_WAIT_L(0); PG8_BAR; PG8_MMA(1, 0, At, B0); PG8_MMA(1, 1, At, B1); PG8_BAR; PG8_SCHED;
            PG8_LDB(B0, 1, 0); PG8_LDB(B1, 1, 1); PG8_SCHED; PG8_LDA(At, 1, 0); PG8_STAGE(PG8_SA(0, 1), a2 + hstep, voffA);
            PG8_WAIT_V(8); PG8_WAIT_L(0); PG8_BAR; PG8_MMA(0, 0, At, B0); PG8_MMA(0, 1, At, B1); PG8_BAR; PG8_SCHED;
            PG8_LDA(At, 1, 1); PG8_STAGE(PG8_SB(1, 0), b3, voffB); PG8_STAGE(PG8_SB(1, 1), b3 + hstep, voffB); PG8_STAGE(PG8_SA(1, 0), a3, voffA);
            PG8_WAIT_V(8); PG8_WAIT_L(0); PG8_BAR; PG8_MMA(1, 0, At, B0); PG8_MMA(1, 1, At, B1); PG8_BAR; PG8_SCHED;
            } else {
            PG8_LDB(B0, 0, 0); PG8_SCHED; PG8_LDA(At, 0, 0); PG8_STAGE(PG8_SA(1, 1), a1 + hstep, voffA);
            PG8_WAIT_L(8); PG8_BAR; PG8_WAIT_L(0); PG8_MMA(0, 0, At, B0); PG8_BAR; PG8_SCHED;
            PG8_LDB(B1, 0, 1); PG8_STAGE(PG8_SB(0, 0), b2, voffB);
            PG8_BAR; PG8_WAIT_L(0); PG8_MMA(0, 1, At, B1); PG8_BAR;
            PG8_LDA(At, 0, 1); PG8_STAGE(PG8_SA(0, 0), a2, voffA);
            PG8_BAR; PG8_WAIT_L(0); PG8_MMA(1, 0, At, B0); PG8_BAR; PG8_SCHED;
            PG8_STAGE(PG8_SB(0, 1), b2 + hstep, voffB);
            PG8_WAIT_V(6); PG8_BAR; PG8_MMA(1, 1, At, B1); PG8_BAR;
            PG8_LDB(B0, 1, 0); PG8_SCHED; PG8_LDA(At, 1, 0); PG8_STAGE(PG8_SA(0, 1), a2 + hstep, voffA);
            PG8_WAIT_L(8); PG8_BAR; PG8_WAIT_L(0); PG8_MMA(0, 0, At, B0); PG8_BAR; PG8_SCHED;
            PG8_LDB(B1, 1, 1); PG8_STAGE(PG8_SB(1, 0), b3, voffB);
            PG8_BAR; PG8_WAIT_L(0); PG8_MMA(0, 1, At, B1); PG8_BAR;
            PG8_LDA(At, 1, 1); PG8_STAGE(PG8_SA(1, 0), a3, voffA);
            PG8_BAR; PG8_WAIT_L(0); PG8_MMA(1, 0, At, B0); PG8_BAR; PG8_SCHED;
            PG8_STAGE(PG8_SB(1, 1), b3 + hstep, voffB);
            PG8_WAIT_V(6); PG8_BAR; PG8_MMA(1, 1, At, B1); PG8_BAR;
            }
        }
        if constexpr (ALIGN_EPI) { if (wr == 0) PG8_BAR; }
        if constexpr (!Epi::AFTER_DRAIN) { E(acc, cur, wr, wc, fr, fq); S.done(cur); }
        if (!has_next) break;
#pragma unroll
        for (int a = 0; a < 2; ++a)
#pragma unroll
            for (int b = 0; b < 2; ++b)
#pragma unroll
                for (int m = 0; m < 4; ++m)
#pragma unroll
                    for (int n = 0; n < 2; ++n) acc[a][b][m][n] = (f32x4){0.f, 0.f, 0.f, 0.f};
        cur = nxt; cA = nA; cB = nB; ++ui;
        if constexpr (ALIGN_EPI) { if (wr == 1) PG8_BAR; }
    }
    PG8_WAIT_V(0);
    if constexpr (!ALIGN_EPI) { if (wr == 0) PG8_BAR; }
    PG8_BAR;
    if constexpr (Epi::AFTER_DRAIN) { E.fused(acc, cur, wr, wc, fr, fq, lds, wid, lane); S.done(cur); }
#undef PG8_SA
#undef PG8_SB
#undef PG8_STAGE
#undef PG8_LDA
#undef PG8_LDB
#undef PG8_MMA
#undef PG8_WAIT_V
#undef PG8_WAIT_L
#undef PG8_BAR
#undef PG8_SCHED
}
}
using pg8::bf16_t; using pg8::bf16x8; using pg8::f32x4; using pg8::u32x4;
#define LAS __attribute__((address_space(3)))
typedef float f32x16 __attribute__((ext_vector_type(16)));
typedef float f32x2_t __attribute__((ext_vector_type(2)));
typedef __bf16 bf16x2_t __attribute__((ext_vector_type(2)));
typedef unsigned u32x2 __attribute__((ext_vector_type(2)));
typedef short s16x4 __attribute__((ext_vector_type(4)));
#define MFMA32(a, b, c) __builtin_amdgcn_mfma_f32_32x32x16_bf16((a), (b), (c), 0, 0, 0)

constexpr int DM = 1024, SEQ = 16384, NBP = 2, MP = NBP * SEQ, NBS = 16, TS = 32, MS = NBS * TS, MT = MP + MS;
constexpr int NIN = 3328, DFF = 2816, NCH = SEQ / 64;
constexpr float EPS = 1e-6f, LOG2E = 1.4426950408889634f;
constexpr int NTHREADS = 512, NWAVES = 8;
constexpr int LDS_BYTES = 155648;
constexpr int EPT_OFF = 131072, EPT_WAVE = 2560;

constexpr size_t OUT_Y = 0, OUT_PAK = 34078720, OUT_PAV = 34603008, OUT_PGLA = 35127296, OUT_PMK = 35192832, OUT_PMV = 35717120,
                 OUT_SAK = 36241408, OUT_SAV = 36503552, OUT_SGLA = 36765696, OUT_TOTAL = 37289984;
constexpr size_t KiB = 1024, MiB = 1024 * 1024;
constexpr size_t WS_WIN = 1 * MiB, WS_WO = 8 * MiB, WS_WMQ = 10 * MiB, WS_WMKV = 12 * MiB, WS_WMO = 16 * MiB, WS_WGU = 18 * MiB, WS_WD = 29 * MiB;
constexpr size_t WS_MN = 35 * MiB, WS_KMP = 36 * MiB, WS_VMTP = 37 * MiB, WS_KMS = 38 * MiB, WS_VMTS = 46 * MiB;
constexpr size_t WS_H = 54 * MiB, WS_Y = 119 * MiB, WS_U = 184 * MiB, WS_DS = WS_U, WS_DEC = 248 * MiB;
constexpr size_t WS_R = 249 * MiB;
constexpr size_t WS_QA = WS_R, WS_KP = WS_QA + 33280 * KiB, WS_VPT = WS_KP + 32 * MiB, WS_KS = WS_VPT + 32 * MiB, WS_VST = WS_KS + 8704 * KiB,
                 WS_QB = WS_VST + 8704 * KiB, WS_KB = WS_QB + 16640 * KiB, WS_VB = WS_KB + 16640 * KiB, WS_RS = WS_VB + 33280 * KiB, WS_LA = WS_RS + 33280 * KiB,
                 WS_END = WS_LA + 33280 * KiB;
constexpr size_t WS_HID = WS_R;
constexpr size_t WS_VBS = WS_VB + 32 * MiB, WS_LAS = WS_LA + 32 * MiB;
constexpr size_t WS_BT1 = WS_END, WS_BT2 = WS_END + 4 * MiB, WS_WMQN = WS_END + 16 * MiB, WS_VMN = WS_WMQN + 2 * MiB;
static_assert(WS_VMN + 1 * MiB <= 512 * MiB, "ws map 3");
constexpr size_t WS_KBT = WS_END, WS_BC = WS_H, WS_SST = WS_H + 32 * MiB;
static_assert(WS_KBT + 16 * MiB <= 512 * MiB && WS_SST + 32 * MiB <= WS_Y, "ws map 2");
static_assert(WS_HID + (size_t)MT * DFF * 2 <= WS_END && WS_END <= 512 * MiB, "ws map");

struct Params { const float* in[28]; float* out; unsigned char* ws; };
enum { I_XP = 0, I_XS, I_MEM, I_CAK, I_CAV, I_SGLA, I_CMK, I_CMV, I_GPREMIX, I_WIN, I_RELB, I_WA2, I_BA, I_GGLA, I_WO, I_GPOSTMIX, I_GPREMEM, I_GMEM,
       I_WMQ, I_WMK, I_WMV, I_WMO, I_GPOSTMEM, I_GPREFFN, I_WG, I_WU, I_WDN, I_GPOSTFFN };

__device__ __forceinline__ unsigned pk2(float lo, float hi) { f32x2_t v = {lo, hi}; bf16x2_t b = __builtin_convertvector(v, bf16x2_t); return __builtin_bit_cast(unsigned, b); }
__device__ __forceinline__ bf16_t f2bf(float f) { return (bf16_t)(pk2(f, 0.f) & 0xffffu); }
__device__ __forceinline__ float bf2f(unsigned b) { return __uint_as_float(b << 16); }
__device__ __forceinline__ int crow(int i, int h) { return (i & 3) + 8 * (i >> 2) + 4 * h; }
__device__ __forceinline__ float wave_sum(float v) {
#pragma unroll
    for (int o = 1; o < 64; o <<= 1) v += __shfl_xor(v, o);
    return v;
}
__device__ __forceinline__ float silu_f(float x) { return x / (1.f + __expf(-x)); }
__device__ __forceinline__ float logsig(float z) { return fminf(z, 0.f) - __logf(1.f + __expf(-fabsf(z))); }
__device__ __forceinline__ bf16x8 pack8(float x0, float x1, float x2, float x3, float x4, float x5, float x6, float x7) {
    u32x4 w; w.x = pk2(x0, x1); w.y = pk2(x2, x3); w.z = pk2(x4, x5); w.w = pk2(x6, x7); return __builtin_bit_cast(bf16x8, w);
}
#define LDS_WAIT() asm volatile("s_waitcnt lgkmcnt(0)" ::: "memory")

#define EPI_LOOP_BEGIN \
    _Pragma("unroll") for (int ai = 0; ai < 2; ++ai) _Pragma("unroll") for (int m = 0; m < 4; ++m) { \
        const int row = u.pm * 256 + ai * 128 + wr * 64 + m * 16 + fr; \
        _Pragma("unroll") for (int bj = 0; bj < 2; ++bj) _Pragma("unroll") for (int n = 0; n < 2; ++n) { \
            const int c = bj * 128 + wc * 32 + n * 16 + fq * 4; const f32x4 v = acc[ai][bj][m][n];
#define EPI_LOOP_END } asm volatile("" ::: "memory"); }

__device__ __forceinline__ void st_bf4(bf16_t* p, f32x4 v) { u32x2 w; w.x = pk2(v[0], v[1]); w.y = pk2(v[2], v[3]); *(u32x2*)p = w; }
__device__ __forceinline__ void st_bf8(bf16_t* p, f32x4 a, f32x4 b) { u32x4 w; w.x = pk2(a[0], a[1]); w.y = pk2(a[2], a[3]); w.z = pk2(b[0], b[1]); w.w = pk2(b[2], b[3]); *(u32x4*)p = w; }


__device__ __forceinline__ void tr_store_bf16(const f32x4 (&acc)[2][2][4][2], LAS unsigned char* tl, bf16_t* dst  , int wr, int wc, int fr, int fq, int lane) {
#pragma unroll
    for (int ai = 0; ai < 2; ++ai)
#pragma unroll
        for (int bj = 0; bj < 2; ++bj)
#pragma unroll
            for (int mh = 0; mh < 2; ++mh) {
#pragma unroll
                for (int mm = 0; mm < 2; ++mm)
#pragma unroll
                    for (int n = 0; n < 2; ++n) { const f32x4 v = acc[ai][bj][2 * mh + mm][n];
#pragma unroll
                        for (int e = 0; e < 4; ++e) *(LAS bf16_t*)(tl + (8 * fq + 4 * n + e) * 80 + (16 * mm + fr) * 2) = f2bf(v[e]); }
#pragma unroll
                for (int k = 0; k < 2; ++k) { const int p = lane + 64 * k, col = p >> 2, pc = p & 3;
                    const u32x4 w = *(const LAS u32x4*)(tl + col * 80 + pc * 16);
                    *(u32x4*)(dst + (size_t)(128 * bj + 32 * wc + col) * SEQ + 128 * ai + 64 * wr + 32 * mh + 8 * pc) = w; }
            }
}
__device__ __forceinline__ void tr_store_la(const f32x4 (&vals)[2][2][4][2], LAS unsigned char* tl, float* dst, const float* b_alpha, int wr, int wc, int fr, int fq, int lane) {
#pragma unroll
    for (int ai = 0; ai < 2; ++ai)
#pragma unroll
        for (int bj = 0; bj < 2; ++bj)
#pragma unroll
            for (int m = 0; m < 4; ++m) {
#pragma unroll
                for (int n = 0; n < 2; ++n) { const f32x4 v = vals[ai][bj][m][n]; const f32x4 bb = *(const f32x4*)(b_alpha + 128 * bj + 32 * wc + 8 * fq + 4 * n);
#pragma unroll
                    for (int e = 0; e < 4; ++e) *(LAS float*)(tl + (8 * fq + 4 * n + e) * 80 + fr * 4) = logsig(v[e] + bb[e]) * 0.0625f; }
#pragma unroll
                for (int k = 0; k < 2; ++k) { const int p = lane + 64 * k, col = p >> 2, pc = p & 3;
                    const f32x4 w = *(const LAS f32x4*)(tl + col * 80 + pc * 16);
                    *(f32x4*)(dst + (size_t)(128 * bj + 32 * wc + col) * SEQ + 128 * ai + 64 * wr + 16 * m + 4 * pc) = w; }
            }
}

struct EpiIn {
    static constexpr bool PERM = true, AFTER_DRAIN = false;
    unsigned char* wsb; const float* b_alpha; float* outb; LAS unsigned char* ept;
    template <int KIND> __device__ __forceinline__ void run(const f32x4 (&acc)[2][2][4][2], const pg8::Unit& u, int wr, int wc, int fr, int fq) const {
        const int pn = u.pn; const bool isP = u.pm < MP / 256;
        __attribute__((address_space(1))) unsigned char* wg_ = (__attribute__((address_space(1))) unsigned char*)wsb; asm volatile("" : "+s"(wg_)); unsigned char* ws = (unsigned char*)wg_;
        __attribute__((address_space(1))) float* og_ = (__attribute__((address_space(1))) float*)outb; asm volatile("" : "+s"(og_)); float* out = (float*)og_;
        bf16_t* QA = (bf16_t*)(ws + WS_QA); bf16_t* KP = (bf16_t*)(ws + WS_KP); bf16_t* VPT = (bf16_t*)(ws + WS_VPT); bf16_t* KS = (bf16_t*)(ws + WS_KS); bf16_t* VST = (bf16_t*)(ws + WS_VST);
        bf16_t* QB = (bf16_t*)(ws + WS_QB); bf16_t* KB = (bf16_t*)(ws + WS_KB); bf16_t* VB = (bf16_t*)(ws + WS_VB); bf16_t* RS = (bf16_t*)(ws + WS_RS); float* LA = (float*)(ws + WS_LA);
        bf16_t* KBT = (bf16_t*)(ws + WS_KBT); bf16_t* VBS = (bf16_t*)(ws + WS_VBS); float* LAS_ = (float*)(ws + WS_LAS);
        (void)QA; (void)KP; (void)VPT; (void)KS; (void)VST; (void)QB; (void)KB; (void)VB; (void)RS; (void)LA; (void)KBT; (void)VBS; (void)LAS_; (void)out;
#pragma unroll
        for (int ai = 0; ai < 2; ++ai)
#pragma unroll
            for (int m = 0; m < 4; ++m) {
                const int row = u.pm * 256 + ai * 128 + wr * 64 + m * 16 + fr; const int rs = row - MP;
                const int pb = row >> 14, pt = row & (SEQ - 1), sb = rs >> 5, st = rs & 31;
#pragma unroll
                for (int bj = 0; bj < 2; ++bj) {
                    const int c = bj * 128 + wc * 32 + 8 * fq;
                    const f32x4 v0 = acc[ai][bj][m][0], v1 = acc[ai][bj][m][1];
                    if constexpr (KIND == 0) {
                        st_bf8(QA + (size_t)row * 512 + pn * 256 + c, v0 * (0.125f * LOG2E), v1 * (0.125f * LOG2E));
                    } else if constexpr (KIND == 1) {
                        const int col = (pn - 2) * 256 + c;
                        if (isP) { st_bf8(KP + (size_t)row * 512 + col, v0, v1);
                                   if (pt >= SEQ - 512) { float* o = out + OUT_PAK + ((size_t)pb * 512 + (pt - (SEQ - 512))) * 512 + col; *(f32x4*)o = v0; *(f32x4*)(o + 4) = v1; } }
                        else     { st_bf8(KS + ((size_t)sb * 544 + 512 + st) * 512 + col, v0, v1);
                                   float* o = out + OUT_SAK + (size_t)rs * 512 + col; *(f32x4*)o = v0; *(f32x4*)(o + 4) = v1; }
                    } else if constexpr (KIND == 2) {
                        const int col = (pn - 4) * 256 + c;
                        if (isP) { if (pt >= SEQ - 512) { float* o = out + OUT_PAV + ((size_t)pb * 512 + (pt - (SEQ - 512))) * 512 + col; *(f32x4*)o = v0; *(f32x4*)(o + 4) = v1; } }
                        else     { bf16_t* p = VST + ((size_t)sb * 512 + col) * 544 + 512 + st;
                                   p[0] = f2bf(v0[0]); p[544] = f2bf(v0[1]); p[2 * 544] = f2bf(v0[2]); p[3 * 544] = f2bf(v0[3]);
                                   p[4 * 544] = f2bf(v1[0]); p[5 * 544] = f2bf(v1[1]); p[6 * 544] = f2bf(v1[2]); p[7 * 544] = f2bf(v1[3]);
                                   float* o = out + OUT_SAV + (size_t)rs * 512 + col; *(f32x4*)o = v0; *(f32x4*)(o + 4) = v1; }
                    } else if constexpr (KIND == 3) {
                        st_bf8(QB + (size_t)row * 256 + c, v0 * 0.125f, v1 * 0.125f);
                    } else if constexpr (KIND == 4) {
                        st_bf8(KB + (size_t)row * 256 + c, v0, v1);
                    } else if constexpr (KIND == 5) {
                        if (!isP) st_bf8(VBS + (size_t)rs * 512 + (pn - 8) * 256 + c, v0, v1);
                    } else if constexpr (KIND == 6) {
                        f32x4 s0, s1; s0[0] = silu_f(v0[0]); s0[1] = silu_f(v0[1]); s0[2] = silu_f(v0[2]); s0[3] = silu_f(v0[3]);
                        s1[0] = silu_f(v1[0]); s1[1] = silu_f(v1[1]); s1[2] = silu_f(v1[2]); s1[3] = silu_f(v1[3]);
                        st_bf8(RS + (size_t)row * 512 + (pn - 10) * 256 + c, s0, s1);
                    } else {
                        if (!isP) { const f32x4 b0 = *(const f32x4*)(b_alpha + c), b1 = *(const f32x4*)(b_alpha + c + 4); f32x4 s0, s1;
                            s0[0] = logsig(v0[0] + b0[0]) * 0.0625f; s0[1] = logsig(v0[1] + b0[1]) * 0.0625f; s0[2] = logsig(v0[2] + b0[2]) * 0.0625f; s0[3] = logsig(v0[3] + b0[3]) * 0.0625f;
                            s1[0] = logsig(v1[0] + b1[0]) * 0.0625f; s1[1] = logsig(v1[1] + b1[1]) * 0.0625f; s1[2] = logsig(v1[2] + b1[2]) * 0.0625f; s1[3] = logsig(v1[3] + b1[3]) * 0.0625f;
                            float* o = LAS_ + (size_t)rs * 256 + c; *(f32x4*)o = s0; *(f32x4*)(o + 4) = s1; }
                    }
                }
                asm volatile("" ::: "memory");
            }
        if (isP) {
            const int lane = threadIdx.x & 63; const int pb0 = (u.pm * 256) >> 14, pt0 = (u.pm * 256) & (SEQ - 1); LAS unsigned char* tl = ept + (threadIdx.x >> 6) * EPT_WAVE;
            if constexpr (KIND == 2) tr_store_bf16(acc, tl, VPT + ((size_t)pb0 * 512 + (pn - 4) * 256) * SEQ + pt0, wr, wc, fr, fq, lane);
            if constexpr (KIND == 4) tr_store_bf16(acc, tl, KBT + ((size_t)pb0 * 256) * SEQ + pt0, wr, wc, fr, fq, lane);
            if constexpr (KIND == 5) tr_store_bf16(acc, tl, VB + ((size_t)pb0 * 512 + (pn - 8) * 256) * SEQ + pt0, wr, wc, fr, fq, lane);
            if constexpr (KIND == 7) tr_store_la(acc, tl, LA + ((size_t)pb0 * 256) * SEQ + pt0, b_alpha, wr, wc, fr, fq, lane);
        }
    }
    __device__ __forceinline__ void operator()(const f32x4 (&acc)[2][2][4][2], const pg8::Unit& u, int wr, int wc, int fr, int fq) const {
        asm volatile("" : "+v"(fr), "+v"(fq));
        const int pn = u.pn;
        if (pn < 2) run<0>(acc, u, wr, wc, fr, fq);
        else if (pn < 4) run<1>(acc, u, wr, wc, fr, fq);
        else if (pn < 6) run<2>(acc, u, wr, wc, fr, fq);
        else if (pn == 6) run<3>(acc, u, wr, wc, fr, fq);
        else if (pn == 7) run<4>(acc, u, wr, wc, fr, fq);
        else if (pn < 10) run<5>(acc, u, wr, wc, fr, fq);
        else if (pn < 12) run<6>(acc, u, wr, wc, fr, fq);
        else run<7>(acc, u, wr, wc, fr, fq);
    }
};


struct EpiMem {
    static constexpr bool PERM = false, AFTER_DRAIN = false;
    bf16_t *KM, *VMT, *VMN; float* out;
    __device__ __forceinline__ void operator()(const f32x4 (&acc)[2][2][4][2], const pg8::Unit& u, int wr, int wc, int fr, int fq) const {
        asm volatile("" : "+v"(fr), "+v"(fq));
        const int pn = u.pn;
        EPI_LOOP_BEGIN
            if (pn < 4) { const int col = pn * 256 + c;
                *(f32x4*)(out + OUT_PMK + (size_t)row * 1024 + col) = v; st_bf4(KM + (size_t)row * 1024 + col, v);
            } else { const int col = (pn - 4) * 256 + c; const int nb = row >> 8, key = row & 255;
                *(f32x4*)(out + OUT_PMV + (size_t)row * 1024 + col) = v; st_bf4(VMN + (size_t)row * 1024 + col, v);
                bf16_t* p = VMT + ((size_t)nb * 1024 + col) * 256 + key;
                p[0] = f2bf(v[0]); p[256] = f2bf(v[1]); p[512] = f2bf(v[2]); p[768] = f2bf(v[3]);
            }
        EPI_LOOP_END
    }
};

struct EpiPlain {
    static constexpr bool PERM = true, AFTER_DRAIN = false;
    bf16_t* O; int ldc; float scale;
    __device__ __forceinline__ void operator()(const f32x4 (&acc)[2][2][4][2], const pg8::Unit& u, int wr, int wc, int fr, int fq) const {
        asm volatile("" : "+v"(fr), "+v"(fq));
#pragma unroll
        for (int ai = 0; ai < 2; ++ai)
#pragma unroll
            for (int m = 0; m < 4; ++m) { const int row = u.pm * 256 + ai * 128 + wr * 64 + m * 16 + fr;
#pragma unroll
                for (int bj = 0; bj < 2; ++bj) st_bf8(O + (size_t)row * ldc + u.pn * 256 + bj * 128 + wc * 32 + 8 * fq, acc[ai][bj][m][0] * scale, acc[ai][bj][m][1] * scale);
                asm volatile("" ::: "memory"); }
    }
};

struct EpiSwiglu {
    static constexpr bool PERM = true, AFTER_DRAIN = false;
    bf16_t* HID;
    __device__ __forceinline__ void operator()(const f32x4 (&acc)[2][2][4][2], const pg8::Unit& u, int wr, int wc, int fr, int fq) const {
        asm volatile("" : "+v"(fr), "+v"(fq));
#pragma unroll
        for (int ai = 0; ai < 2; ++ai)
#pragma unroll
            for (int m = 0; m < 4; ++m) {
                const int row = u.pm * 256 + ai * 128 + wr * 64 + m * 16 + fr; f32x4 s[2];
#pragma unroll
                for (int n = 0; n < 2; ++n) { const f32x4 g = acc[ai][0][m][n], up = acc[ai][1][m][n];
                    s[n][0] = silu_f(g[0]) * up[0]; s[n][1] = silu_f(g[1]) * up[1]; s[n][2] = silu_f(g[2]) * up[2]; s[n][3] = silu_f(g[3]) * up[3]; }
                st_bf8(HID + (size_t)row * DFF + u.pn * 128 + wc * 32 + 8 * fq, s[0], s[1]);
                asm volatile("" ::: "memory");
            }
    }
};

struct OrderMem {
    pg8::StaticOrder S;
    __device__ bool next(int i, pg8::Unit& u) const { if (!S.next(i, u)) return false; u.pn += (u.pm >= SEQ / 256) ? 4 : 0; return true; }
    __device__ __forceinline__ void a_ready(const pg8::Unit&) const {}
    __device__ __forceinline__ void done(const pg8::Unit&) const {}
};
struct EpiPlainM {
    static constexpr bool PERM = true, AFTER_DRAIN = false;
    bf16_t* O;
    __device__ __forceinline__ void operator()(const f32x4 (&acc)[2][2][4][2], const pg8::Unit& u, int wr, int wc, int fr, int fq) const {
        asm volatile("" : "+v"(fr), "+v"(fq));
#pragma unroll
        for (int ai = 0; ai < 2; ++ai)
#pragma unroll
            for (int m = 0; m < 4; ++m) { const int row = u.pm * 256 + ai * 128 + wr * 64 + m * 16 + fr;
#pragma unroll
                for (int bj = 0; bj < 2; ++bj) st_bf8(O + (size_t)row * 1024 + (u.pn & 3) * 256 + bj * 128 + wc * 32 + 8 * fq, acc[ai][bj][m][0], acc[ai][bj][m][1]);
                asm volatile("" ::: "memory"); }
    }
};
struct EpiSoftmax {
    static constexpr bool PERM = true, AFTER_DRAIN = false;
    bf16_t* O; LAS unsigned char* xl;
    __device__ __forceinline__ void operator()(const f32x4 (&acc_)[2][2][4][2], const pg8::Unit& u, int wr, int wc, int fr, int fq) const {
        asm volatile("" : "+v"(fr), "+v"(fq));
        f32x4 (&acc)[2][2][4][2] = const_cast<f32x4 (&)[2][2][4][2]>(acc_);
        LAS float* MX = (LAS float*)xl; LAS float* SM = (LAS float*)(xl + 4096);
#pragma unroll
        for (int ai = 0; ai < 2; ++ai)
#pragma unroll
            for (int m = 0; m < 4; ++m) { float mx = -INFINITY;
#pragma unroll
                for (int bj = 0; bj < 2; ++bj)
#pragma unroll
                    for (int n = 0; n < 2; ++n) { const f32x4 v = acc[ai][bj][m][n]; mx = fmaxf(fmaxf(mx, fmaxf(v[0], v[1])), fmaxf(v[2], v[3])); }
                mx = fmaxf(mx, __shfl_xor(mx, 16)); mx = fmaxf(mx, __shfl_xor(mx, 32));
                if (fq == 0) MX[(ai * 128 + wr * 64 + m * 16 + fr) * 4 + wc] = mx; }
        asm volatile("s_waitcnt lgkmcnt(0)" ::: "memory"); __builtin_amdgcn_s_barrier(); asm volatile("" ::: "memory");
#pragma unroll
        for (int ai = 0; ai < 2; ++ai)
#pragma unroll
            for (int m = 0; m < 4; ++m) { const f32x4 mv = *(const LAS f32x4*)(MX + (ai * 128 + wr * 64 + m * 16 + fr) * 4);
                const float mx = fmaxf(fmaxf(mv[0], mv[1]), fmaxf(mv[2], mv[3])); float sum = 0.f;
#pragma unroll
                for (int bj = 0; bj < 2; ++bj)
#pragma unroll
                    for (int n = 0; n < 2; ++n) { f32x4 v = acc[ai][bj][m][n];
                        v[0] = __builtin_amdgcn_exp2f(v[0] - mx); v[1] = __builtin_amdgcn_exp2f(v[1] - mx); v[2] = __builtin_amdgcn_exp2f(v[2] - mx); v[3] = __builtin_amdgcn_exp2f(v[3] - mx);
                        acc[ai][bj][m][n] = v; sum += (v[0] + v[1]) + (v[2] + v[3]); }
                sum += __shfl_xor(sum, 16); sum += __shfl_xor(sum, 32);
                if (fq == 0) SM[(ai * 128 + wr * 64 + m * 16 + fr) * 4 + wc] = sum; }
        asm volatile("s_waitcnt lgkmcnt(0)" ::: "memory"); __builtin_amdgcn_s_barrier(); asm volatile("" ::: "memory");
#pragma unroll
        for (int ai = 0; ai < 2; ++ai)
#pragma unroll
            for (int m = 0; m < 4; ++m) { const int rl = ai * 128 + wr * 64 + m * 16 + fr; const f32x4 sv = *(const LAS f32x4*)(SM + rl * 4);
                const float inv = 1.f / ((sv[0] + sv[1]) + (sv[2] + sv[3])); const size_t row = (size_t)u.pm * 256 + rl;
#pragma unroll
                for (int bj = 0; bj < 2; ++bj) st_bf8(O + row * 1024 + (u.pn & 3) * 256 + bj * 128 + wc * 32 + 8 * fq, acc[ai][bj][m][0] * inv, acc[ai][bj][m][1] * inv); }
    }
};
__device__ __forceinline__ void pre_tile(const bf16_t* A, int lda, const bf16_t* Bt, int ldb, bf16_t* O, int ldo, float scale, int lane) {
    const int r = lane & 31, h = lane >> 5; f32x16 a0, a1;
#pragma unroll
    for (int i = 0; i < 16; ++i) { a0[i] = 0.f; a1[i] = 0.f; }
#pragma unroll
    for (int s = 0; s < 16; s += 2) {
        a0 = MFMA32(*(const bf16x8*)(A + (size_t)r * lda + 16 * s + 8 * h), *(const bf16x8*)(Bt + (size_t)r * ldb + 16 * s + 8 * h), a0);
        a1 = MFMA32(*(const bf16x8*)(A + (size_t)r * lda + 16 * (s + 1) + 8 * h), *(const bf16x8*)(Bt + (size_t)r * ldb + 16 * (s + 1) + 8 * h), a1); }
#pragma unroll
    for (int i = 0; i < 16; ++i) O[(size_t)crow(i, h) * ldo + r] = f2bf((a0[i] + a1[i]) * scale);
}
__device__ __forceinline__ void tr_item(const float* src, int lds_, bf16_t* dst, int ldd, int k0, int n0, int drow0, LAS float* scr, int lane) {
#pragma unroll
    for (int i = 0; i < 8; ++i) { const int kk = 8 * i + (lane >> 3), n4 = (lane & 7) * 4;
        const f32x4 w4 = __builtin_nontemporal_load((const f32x4*)(src + (size_t)(k0 + kk) * lds_ + n0 + n4));
        scr[kk * 33 + n4] = w4[0]; scr[kk * 33 + n4 + 1] = w4[1]; scr[kk * 33 + n4 + 2] = w4[2]; scr[kk * 33 + n4 + 3] = w4[3]; }
    LDS_WAIT();
    const int c = lane & 7;
#pragma unroll
    for (int j = 0; j < 4; ++j) { const int n = (lane >> 3) + 8 * j; const LAS float* s = scr + (8 * c) * 33 + n;
        u32x4 o; o.x = pk2(s[0 * 33], s[1 * 33]); o.y = pk2(s[2 * 33], s[3 * 33]); o.z = pk2(s[4 * 33], s[5 * 33]); o.w = pk2(s[6 * 33], s[7 * 33]);
        *(u32x4*)(dst + (size_t)(drow0 + n) * ldd + k0 + 8 * c) = o; }
    LDS_WAIT();
}
template <int NR>
__device__ __forceinline__ void rms_rows_bf16(const float* const (&xrow)[NR], const f32x4 (&gg)[2][2], bf16_t* const (&orow)[NR], int lane) {
    f32x4 v[NR][2][2]; float s[NR];
#pragma unroll
    for (int q = 0; q < NR; ++q)
#pragma unroll
        for (int j = 0; j < 2; ++j)
#pragma unroll
            for (int hf = 0; hf < 2; ++hf) v[q][j][hf] = __builtin_nontemporal_load((const f32x4*)(xrow[q] + 512 * j + 8 * lane + 4 * hf));
#pragma unroll
    for (int q = 0; q < NR; ++q) { s[q] = 0.f;
#pragma unroll
        for (int j = 0; j < 2; ++j)
#pragma unroll
            for (int hf = 0; hf < 2; ++hf) s[q] += (v[q][j][hf][0] * v[q][j][hf][0] + v[q][j][hf][1] * v[q][j][hf][1]) + (v[q][j][hf][2] * v[q][j][hf][2] + v[q][j][hf][3] * v[q][j][hf][3]); }
#pragma unroll
    for (int q = 0; q < NR; ++q) { const float rstd = rsqrtf(wave_sum(s[q]) * (1.f / DM) + EPS);
#pragma unroll
        for (int j = 0; j < 2; ++j) { const f32x4 a = v[q][j][0] * rstd * gg[j][0], b2 = v[q][j][1] * rstd * gg[j][1]; u32x4 w_;
            w_.x = pk2(a[0], a[1]); w_.y = pk2(a[2], a[3]); w_.z = pk2(b2[0], b2[1]); w_.w = pk2(b2[2], b2[3]);
            *(u32x4*)(orow[q] + 512 * j + 8 * lane) = w_; } }
}
struct RowGains { f32x4 gp[2][2], gn[2][2]; bool has_next; };
__device__ __forceinline__ RowGains load_gains(const float* gpost, const float* gnext, int lane) {
    RowGains g; g.has_next = gnext != nullptr;
#pragma unroll
    for (int j = 0; j < 2; ++j)
#pragma unroll
        for (int hf = 0; hf < 2; ++hf) { g.gp[j][hf] = *(const f32x4*)(gpost + 512 * j + 8 * lane + 4 * hf);
            g.gn[j][hf] = gnext ? *(const f32x4*)(gnext + 512 * j + 8 * lane + 4 * hf) : (f32x4){0.f, 0.f, 0.f, 0.f}; }
    return g;
}
__device__ __forceinline__ void unpack8(u32x4 w, f32x4& a, f32x4& b) {
    a[0] = bf2f(w.x & 0xffffu); a[1] = bf2f(w.x >> 16); a[2] = bf2f(w.y & 0xffffu); a[3] = bf2f(w.y >> 16);
    b[0] = bf2f(w.z & 0xffffu); b[1] = bf2f(w.z >> 16); b[2] = bf2f(w.w & 0xffffu); b[3] = bf2f(w.w >> 16); }
__device__ __forceinline__ float sq4(f32x4 v) { return (v[0] * v[0] + v[1] * v[1]) + (v[2] * v[2] + v[3] * v[3]); }
template <int NR, bool XI16, bool XO16>
__device__ __forceinline__ void rowpass_rows(const bf16_t* const (&urow)[NR], const void* const (&xin)[NR], const RowGains& G, void* const (&xout)[NR], bf16_t* const (&hout)[NR], int lane) {
    f32x4 uu[NR][2][2], xx[NR][2][2]; float s[NR], s2[NR];
#pragma unroll
    for (int q = 0; q < NR; ++q)
#pragma unroll
        for (int j = 0; j < 2; ++j) { const int c0 = 512 * j + 8 * lane;
            unpack8(__builtin_nontemporal_load((const u32x4*)(urow[q] + c0)), uu[q][j][0], uu[q][j][1]);
            if constexpr (XI16) unpack8(__builtin_nontemporal_load((const u32x4*)((const bf16_t*)xin[q] + c0)), xx[q][j][0], xx[q][j][1]);
            else { xx[q][j][0] = __builtin_nontemporal_load((const f32x4*)((const float*)xin[q] + c0)); xx[q][j][1] = __builtin_nontemporal_load((const f32x4*)((const float*)xin[q] + c0 + 4)); } }
#pragma unroll
    for (int q = 0; q < NR; ++q) s[q] = (sq4(uu[q][0][0]) + sq4(uu[q][0][1])) + (sq4(uu[q][1][0]) + sq4(uu[q][1][1]));
#pragma unroll
    for (int q = 0; q < NR; ++q) { const float rstd = rsqrtf(wave_sum(s[q]) * (1.f / DM) + EPS); s2[q] = 0.f;
#pragma unroll
        for (int j = 0; j < 2; ++j) { const int c0 = 512 * j + 8 * lane;
#pragma unroll
            for (int hf = 0; hf < 2; ++hf) { uu[q][j][hf] = xx[q][j][hf] + uu[q][j][hf] * rstd * G.gp[j][hf]; s2[q] += sq4(uu[q][j][hf]); }
            if constexpr (XO16) { u32x4 w_; w_.x = pk2(uu[q][j][0][0], uu[q][j][0][1]); w_.y = pk2(uu[q][j][0][2], uu[q][j][0][3]); w_.z = pk2(uu[q][j][1][0], uu[q][j][1][1]); w_.w = pk2(uu[q][j][1][2], uu[q][j][1][3]);
                __builtin_nontemporal_store(w_, (u32x4*)((bf16_t*)xout[q] + c0)); }
            else { __builtin_nontemporal_store(uu[q][j][0], (f32x4*)((float*)xout[q] + c0)); __builtin_nontemporal_store(uu[q][j][1], (f32x4*)((float*)xout[q] + c0 + 4)); } } }
    if (G.has_next) {
#pragma unroll
        for (int q = 0; q < NR; ++q) { const float r2 = rsqrtf(wave_sum(s2[q]) * (1.f / DM) + EPS);
#pragma unroll
            for (int j = 0; j < 2; ++j) { u32x4 w_; const f32x4 a = uu[q][j][0] * r2 * G.gn[j][0], b2 = uu[q][j][1] * r2 * G.gn[j][1];
                w_.x = pk2(a[0], a[1]); w_.y = pk2(a[2], a[3]); w_.z = pk2(b2[0], b2[1]); w_.w = pk2(b2[2], b2[3]);
                *(u32x4*)(hout[q] + 512 * j + 8 * lane) = w_; } }
    }
}
__device__ __forceinline__ const float* xrow_ptr(const float* xp, const float* xs, int m) { return m < MP ? xp + (size_t)m * DM : xs + (size_t)(m - MP) * DM; }

constexpr int BA_KP = 144, BA_VP = 80, BA_VOFF = 32 * BA_KP, BA_WAVE = BA_VOFF + 64 * BA_VP, BA_TAB = 8 * 640 * 4;
__device__ __forceinline__ void band_core(const bf16_t* Qg, const bf16_t* Kp, int ldk, const bf16_t* VTp, int ldvt, int j0, int j1,
                                          const LAS float* rev, int qpos0, bf16_t* Op, LAS unsigned char* wl, int lane) {
    const int r = lane & 31, h = lane >> 5;
    bf16x8 qf[4];
#pragma unroll
    for (int s = 0; s < 4; ++s) qf[s] = *(const bf16x8*)(Qg + (size_t)r * 512 + 16 * s + 8 * h);
    f32x16 o[2];
#pragma unroll
    for (int dt = 0; dt < 2; ++dt)
#pragma unroll
        for (int i = 0; i < 16; ++i) o[dt][i] = 0.f;
    float m_run = -INFINITY, l_run = 0.f;
    const int krl = lane >> 3, kpc = lane & 7, vrl = lane >> 2, vpc = lane & 3;
    u32x4 kst[4], vst[4];
#pragma unroll
    for (int i = 0; i < 4; ++i) { kst[i] = *(const u32x4*)(Kp + (long)(j0 + krl + 8 * i) * ldk + 8 * kpc); vst[i] = *(const u32x4*)(VTp + (long)(vrl + 16 * i) * ldvt + j0 + 8 * vpc); }
    for (int jt = j0; jt < j1; jt += 32) {
#pragma unroll
        for (int i = 0; i < 4; ++i) { *(LAS u32x4*)(wl + (krl + 8 * i) * BA_KP + 16 * kpc) = kst[i]; *(LAS u32x4*)(wl + BA_VOFF + (vrl + 16 * i) * BA_VP + 16 * vpc) = vst[i]; }
        { const int jn = (jt + 32 < j1) ? jt + 32 : jt;
#pragma unroll
          for (int i = 0; i < 4; ++i) { kst[i] = *(const u32x4*)(Kp + (long)(jn + krl + 8 * i) * ldk + 8 * kpc); vst[i] = *(const u32x4*)(VTp + (long)(vrl + 16 * i) * ldvt + jn + 8 * vpc); } }
        f32x16 sacc;
#pragma unroll
        for (int i = 0; i < 16; ++i) sacc[i] = 0.f;
#pragma unroll
        for (int s = 0; s < 4; ++s) sacc = MFMA32(*(const LAS bf16x8*)(wl + r * BA_KP + (16 * s + 8 * h) * 2), qf[s], sacc);
        const LAS float* rb = rev + (576 - qpos0 - r + jt + 4 * h);
        float mx = -INFINITY;
#pragma unroll
        for (int i = 0; i < 16; ++i) { const float t = sacc[i] + rb[(i & 3) + 8 * (i >> 2)]; sacc[i] = t; mx = fmaxf(mx, t); }
        mx = fmaxf(mx, __shfl_xor(mx, 32));
        const float m_new = fmaxf(m_run, mx); const float alpha = __builtin_amdgcn_exp2f(m_run - m_new); m_run = m_new;
        float ps = 0.f;
#pragma unroll
        for (int i = 0; i < 16; ++i) { const float p = __builtin_amdgcn_exp2f(sacc[i] - m_new); sacc[i] = p; ps += p; }
        l_run = l_run * alpha + ps;
        if (__any(alpha != 1.f)) {
#pragma unroll
            for (int dt = 0; dt < 2; ++dt)
#pragma unroll
                for (int i = 0; i < 16; ++i) o[dt][i] *= alpha;
        }
        bf16x8 pf[2];
        pf[0] = pack8(sacc[0], sacc[1], sacc[2], sacc[3], sacc[4], sacc[5], sacc[6], sacc[7]);
        pf[1] = pack8(sacc[8], sacc[9], sacc[10], sacc[11], sacc[12], sacc[13], sacc[14], sacc[15]);
#pragma unroll
        for (int dt = 0; dt < 2; ++dt)
#pragma unroll
            for (int s2 = 0; s2 < 2; ++s2) {
                const LAS unsigned char* vp = wl + BA_VOFF + (32 * dt + r) * BA_VP + (16 * s2 + 4 * h) * 2;
                const s16x4 lo = *(const LAS s16x4*)vp, hi = *(const LAS s16x4*)(vp + 16);
                bf16x8 vf; vf[0] = lo[0]; vf[1] = lo[1]; vf[2] = lo[2]; vf[3] = lo[3]; vf[4] = hi[0]; vf[5] = hi[1]; vf[6] = hi[2]; vf[7] = hi[3];
                o[dt] = MFMA32(vf, pf[s2], o[dt]);
            }
    }
    const float l = l_run + __shfl_xor(l_run, 32); const float inv = 1.f / l;
#pragma unroll
    for (int dt = 0; dt < 2; ++dt)
#pragma unroll
        for (int g = 0; g < 4; ++g) {
            f32x4 v; v[0] = o[dt][4 * g] * inv; v[1] = o[dt][4 * g + 1] * inv; v[2] = o[dt][4 * g + 2] * inv; v[3] = o[dt][4 * g + 3] * inv;
            st_bf4(Op + (size_t)r * 1024 + 32 * dt + 8 * g + 4 * h, v);
        }
}

__device__ __forceinline__ void band_core64(const bf16_t* Qg, const bf16_t* Kp, int ldk, const bf16_t* VTp, int ldvt, int j0, int j1,
                                            const LAS float* rev, bf16_t* Op, LAS unsigned char* wl, int lane) {
    const int r = lane & 31, h = lane >> 5;
    bf16x8 qf[2][4];
    {
        const int qr_ = lane >> 3, qp_ = lane & 7; u32x4 qs[8];
#pragma unroll
        for (int i = 0; i < 8; ++i) qs[i] = *(const u32x4*)(Qg + (size_t)(qr_ + 8 * i) * 512 + 8 * qp_);
#pragma unroll
        for (int i = 0; i < 8; ++i) *(LAS u32x4*)(wl + (qr_ + 8 * i) * 144 + 16 * qp_) = qs[i];
#pragma unroll
        for (int qt = 0; qt < 2; ++qt)
#pragma unroll
            for (int s = 0; s < 4; ++s) qf[qt][s] = *(const LAS bf16x8*)(wl + (32 * qt + r) * 144 + (16 * s + 8 * h) * 2);
    }
    f32x16 o[2][2];
#pragma unroll
    for (int qt = 0; qt < 2; ++qt)
#pragma unroll
        for (int dt = 0; dt < 2; ++dt)
#pragma unroll
            for (int i = 0; i < 16; ++i) o[qt][dt][i] = 0.f;
    float m_run[2] = {-INFINITY, -INFINITY}, l_run[2] = {0.f, 0.f};
    const float bfar = rev[0];
    const int krl = lane >> 3, kpc = lane & 7, vrl = lane >> 2, vpc = lane & 3;
    u32x4 kst[4], vst[4];
#pragma unroll
    for (int i = 0; i < 4; ++i) { kst[i] = *(const u32x4*)(Kp + (long)(j0 + krl + 8 * i) * ldk + 8 * kpc); vst[i] = *(const u32x4*)(VTp + (long)(vrl + 16 * i) * ldvt + j0 + 8 * vpc); }
    for (int jt = j0; jt < j1; jt += 32) {
#pragma unroll
        for (int i = 0; i < 4; ++i) { *(LAS u32x4*)(wl + (krl + 8 * i) * BA_KP + 16 * kpc) = kst[i]; *(LAS u32x4*)(wl + BA_VOFF + (vrl + 16 * i) * BA_VP + 16 * vpc) = vst[i]; }
        { const int jn = (jt + 32 < j1) ? jt + 32 : jt;
#pragma unroll
          for (int i = 0; i < 4; ++i) { kst[i] = *(const u32x4*)(Kp + (long)(jn + krl + 8 * i) * ldk + 8 * kpc); vst[i] = *(const u32x4*)(VTp + (long)(vrl + 16 * i) * ldvt + jn + 8 * vpc); } }
        f32x16 sa[2];
#pragma unroll
        for (int i = 0; i < 16; ++i) { sa[0][i] = 0.f; sa[1][i] = 0.f; }
#pragma unroll
        for (int s = 0; s < 4; ++s) { const bf16x8 kf = *(const LAS bf16x8*)(wl + r * BA_KP + (16 * s + 8 * h) * 2);
            sa[0] = MFMA32(kf, qf[0][s], sa[0]); sa[1] = MFMA32(kf, qf[1][s], sa[1]); }
        bf16x8 pf[2][2];
#pragma unroll
        for (int qt = 0; qt < 2; ++qt) {
            float mx = -INFINITY;
            if (jt <= 224 + 32 * qt) {
#pragma unroll
                for (int i = 0; i < 16; ++i) { const float t = sa[qt][i] + bfar; sa[qt][i] = t; mx = fmaxf(mx, t); }
            } else {
                const LAS float* rb = rev + (64 - 32 * qt - r + jt + 4 * h);
#pragma unroll
                for (int i = 0; i < 16; ++i) { const float t = sa[qt][i] + rb[(i & 3) + 8 * (i >> 2)]; sa[qt][i] = t; mx = fmaxf(mx, t); }
            }
            mx = fmaxf(mx, __shfl_xor(mx, 32));
            const float m_new = fmaxf(m_run[qt], mx); const float alpha = __builtin_amdgcn_exp2f(m_run[qt] - m_new); m_run[qt] = m_new;
            float ps = 0.f;
#pragma unroll
            for (int i = 0; i < 16; ++i) { const float p = __builtin_amdgcn_exp2f(sa[qt][i] - m_new); sa[qt][i] = p; ps += p; }
            l_run[qt] = l_run[qt] * alpha + ps;
            if (__any(alpha != 1.f)) {
#pragma unroll
                for (int dt = 0; dt < 2; ++dt)
#pragma unroll
                    for (int i = 0; i < 16; ++i) o[qt][dt][i] *= alpha;
            }
            pf[qt][0] = pack8(sa[qt][0], sa[qt][1], sa[qt][2], sa[qt][3], sa[qt][4], sa[qt][5], sa[qt][6], sa[qt][7]);
            pf[qt][1] = pack8(sa[qt][8], sa[qt][9], sa[qt][10], sa[qt][11], sa[qt][12], sa[qt][13], sa[qt][14], sa[qt][15]);
        }
#pragma unroll
        for (int dt = 0; dt < 2; ++dt)
#pragma unroll
            for (int s2 = 0; s2 < 2; ++s2) {
                const LAS unsigned char* vp = wl + BA_VOFF + (32 * dt + r) * BA_VP + (16 * s2 + 4 * h) * 2;
                const s16x4 lo = *(const LAS s16x4*)vp, hi = *(const LAS s16x4*)(vp + 16);
                bf16x8 vf; vf[0] = lo[0]; vf[1] = lo[1]; vf[2] = lo[2]; vf[3] = lo[3]; vf[4] = hi[0]; vf[5] = hi[1]; vf[6] = hi[2]; vf[7] = hi[3];
                o[0][dt] = MFMA32(vf, pf[0][s2], o[0][dt]); o[1][dt] = MFMA32(vf, pf[1][s2], o[1][dt]);
            }
    }
#pragma unroll
    for (int qt = 0; qt < 2; ++qt) {
        const float l = l_run[qt] + __shfl_xor(l_run[qt], 32); const float inv = 1.f / l;
#pragma unroll
        for (int dt = 0; dt < 2; ++dt)
#pragma unroll
            for (int g = 0; g < 4; ++g) { u32x2 w2; w2.x = pk2(o[qt][dt][4 * g] * inv, o[qt][dt][4 * g + 1] * inv); w2.y = pk2(o[qt][dt][4 * g + 2] * inv, o[qt][dt][4 * g + 3] * inv);
                *(LAS u32x2*)(wl + (32 * qt + r) * 144 + (32 * dt + 8 * g + 4 * h) * 2) = w2; }
    }
#pragma unroll
    for (int k = 0; k < 8; ++k) { const int p = lane + 64 * k, row = p >> 3, pc = p & 7;
        *(u32x4*)(Op + (size_t)row * 1024 + 8 * pc) = *(const LAS u32x4*)(wl + row * 144 + 16 * pc); }
}

constexpr int GA_WAVE = 64 * 144;
__device__ __forceinline__ void gla_wave_a(LAS unsigned char* wl, const float* LAT, const bf16_t* KBT, const bf16_t* VBT, float* BC, float* DST, float* DEC, int unit, int lane) {
    const int c = unit & (NCH - 1), bh = unit >> 8, hb = bh & 3, b = bh >> 2;
    const size_t row0 = (size_t)b * SEQ + (size_t)c * 64;
    const int r = lane & 31, h = lane >> 5;
    float bc[64];
    { const float* lp = LAT + ((size_t)bh * 64 + lane) * SEQ + c * 64;
#pragma unroll
      for (int i = 0; i < 16; ++i) { const f32x4 v = *(const f32x4*)(lp + 4 * i); bc[4 * i] = v[0]; bc[4 * i + 1] = v[1]; bc[4 * i + 2] = v[2]; bc[4 * i + 3] = v[3]; } }
    u32x4 kk[8];
    { const bf16_t* kp = KBT + ((size_t)bh * 64 + lane) * SEQ + c * 64;
#pragma unroll
      for (int i = 0; i < 8; ++i) kk[i] = *(const u32x4*)(kp + 8 * i); }
#pragma unroll
    for (int t = 1; t < 64; ++t) bc[t] += bc[t - 1];
    { float* bp = BC + row0 * 256 + hb * 64 + lane;
#pragma unroll
      for (int t = 0; t < 64; ++t) bp[(size_t)t * 256] = bc[t]; }
    const float bl = bc[63];
    DEC[(size_t)unit * 64 + lane] = __expf(bl);
#pragma unroll
    for (int i = 0; i < 8; ++i) { u32x4 w;
#pragma unroll
        for (int e = 0; e < 4; ++e) { const unsigned kw = kk[i][e]; const int t = 8 * i + 2 * e;
            w[e] = pk2(bf2f(kw & 0xffffu) * __expf(bl - bc[t]), bf2f(kw >> 16) * __expf(bl - bc[t + 1])); }
        *(LAS u32x4*)(wl + lane * 144 + 16 * i) = w; }
    const bf16_t* vbase = VBT + ((size_t)bh * 128) * SEQ + c * 64;
    float* dst = DST + (size_t)unit * 8192;
#pragma unroll 1
    for (int dvt = 0; dvt < 4; ++dvt) {
        f32x16 a0, a1;
#pragma unroll
        for (int i = 0; i < 16; ++i) { a0[i] = 0.f; a1[i] = 0.f; }
#pragma unroll
        for (int s = 0; s < 4; ++s) {
            const bf16x8 va = *(const bf16x8*)(vbase + (size_t)(32 * dvt + r) * SEQ + 16 * s + 8 * h);
            a0 = MFMA32(va, *(const LAS bf16x8*)(wl + r * 144 + (16 * s + 8 * h) * 2), a0);
            a1 = MFMA32(va, *(const LAS bf16x8*)(wl + (32 + r) * 144 + (16 * s + 8 * h) * 2), a1);
        }
#pragma unroll
        for (int i = 0; i < 16; ++i) { float* p = dst + (32 * dvt + crow(i, h)) * 64 + r; p[0] = a0[i]; p[32] = a1[i]; }
    }
}

constexpr int GB_P = 272, GB_WAVE = 18176;
__device__ __forceinline__ void gla_wave_b(LAS unsigned char* wl, const float* BC, const bf16_t* QB, const bf16_t* KB, const bf16_t* VBT, const bf16_t* SST, const bf16_t* RS, const float* ggla, bf16_t* Y, int unit, int lane) {
    const int c = unit & (NCH - 1), bh = unit >> 8, hb = bh & 3, b = bh >> 2;
    const size_t row0 = (size_t)b * SEQ + (size_t)c * 64;
    const int r = lane & 31, h = lane >> 5;
    bf16x8 qt[2][4], kt[2][4];
    {
        const int br_ = lane >> 4, bp_ = lane & 15, qr_ = lane >> 3, qp_ = lane & 7;
        f32x4 bst[2][8]; u32x4 qst[2][4], kst[2][4];
#pragma unroll
        for (int rt = 0; rt < 2; ++rt) {
#pragma unroll
            for (int i = 0; i < 8; ++i) bst[rt][i] = *(const f32x4*)(BC + (row0 + 32 * rt + br_ + 4 * i) * 256 + hb * 64 + 4 * bp_);
#pragma unroll
            for (int i = 0; i < 4; ++i) { qst[rt][i] = *(const u32x4*)(QB + (row0 + 32 * rt + qr_ + 8 * i) * 256 + hb * 64 + 8 * qp_); kst[rt][i] = *(const u32x4*)(KB + (row0 + 32 * rt + qr_ + 8 * i) * 256 + hb * 64 + 8 * qp_); }
        }
#pragma unroll
        for (int rt = 0; rt < 2; ++rt) {
#pragma unroll
            for (int i = 0; i < 8; ++i) *(LAS f32x4*)(wl + (br_ + 4 * i) * 272 + 16 * bp_) = bst[rt][i];
#pragma unroll
            for (int i = 0; i < 4; ++i) { *(LAS u32x4*)(wl + 8704 + (qr_ + 8 * i) * 144 + 16 * qp_) = qst[rt][i]; *(LAS u32x4*)(wl + 13312 + (qr_ + 8 * i) * 144 + 16 * qp_) = kst[rt][i]; }
#pragma unroll
            for (int s = 0; s < 4; ++s) {
                const f32x4 b0 = *(const LAS f32x4*)(wl + r * 272 + (16 * s + 8 * h) * 4), b1 = *(const LAS f32x4*)(wl + r * 272 + (16 * s + 8 * h) * 4 + 16);
                const u32x4 qw = *(const LAS u32x4*)(wl + 8704 + r * 144 + (16 * s + 8 * h) * 2), kw = *(const LAS u32x4*)(wl + 13312 + r * 144 + (16 * s + 8 * h) * 2);
                float e[8], qv[8], kv[8];
#pragma unroll
                for (int j = 0; j < 4; ++j) { e[j] = __expf(b0[j]); e[4 + j] = __expf(b1[j]); }
#pragma unroll
                for (int j = 0; j < 4; ++j) { qv[2 * j] = bf2f(qw[j] & 0xffffu) * e[2 * j]; qv[2 * j + 1] = bf2f(qw[j] >> 16) * e[2 * j + 1];
                    kv[2 * j] = bf2f(kw[j] & 0xffffu) * __builtin_amdgcn_rcpf(e[2 * j]); kv[2 * j + 1] = bf2f(kw[j] >> 16) * __builtin_amdgcn_rcpf(e[2 * j + 1]); }
                qt[rt][s] = pack8(qv[0], qv[1], qv[2], qv[3], qv[4], qv[5], qv[6], qv[7]);
                kt[rt][s] = pack8(kv[0], kv[1], kv[2], kv[3], kv[4], kv[5], kv[6], kv[7]);
            }
        }
    }
    f32x16 t00, t01, t11;
#pragma unroll
    for (int i = 0; i < 16; ++i) { t00[i] = 0.f; t01[i] = 0.f; t11[i] = 0.f; }
#pragma unroll
    for (int s = 0; s < 4; ++s) { t00 = MFMA32(kt[0][s], qt[0][s], t00); t01 = MFMA32(kt[0][s], qt[1][s], t01); t11 = MFMA32(kt[1][s], qt[1][s], t11); }
#pragma unroll
    for (int i = 0; i < 16; ++i) { const bool keep = crow(i, h) <= r; t00[i] = keep ? t00[i] : 0.f; t11[i] = keep ? t11[i] : 0.f; }
    bf16x8 p00[2], p01[2], p11[2];
#pragma unroll
    for (int s2 = 0; s2 < 2; ++s2) {
        p00[s2] = pack8(t00[8 * s2], t00[8 * s2 + 1], t00[8 * s2 + 2], t00[8 * s2 + 3], t00[8 * s2 + 4], t00[8 * s2 + 5], t00[8 * s2 + 6], t00[8 * s2 + 7]);
        p01[s2] = pack8(t01[8 * s2], t01[8 * s2 + 1], t01[8 * s2 + 2], t01[8 * s2 + 3], t01[8 * s2 + 4], t01[8 * s2 + 5], t01[8 * s2 + 6], t01[8 * s2 + 7]);
        p11[s2] = pack8(t11[8 * s2], t11[8 * s2 + 1], t11[8 * s2 + 2], t11[8 * s2 + 3], t11[8 * s2 + 4], t11[8 * s2 + 5], t11[8 * s2 + 6], t11[8 * s2 + 7]);
    }
    const bf16_t* vbase = VBT + ((size_t)bh * 128) * SEQ + c * 64;
    const bf16_t* sbase = SST + (size_t)unit * 8192;
    float ss0 = 0.f, ss1 = 0.f;
#pragma unroll 1
    for (int dvt = 0; dvt < 4; ++dvt) {
        f32x16 o0, o1;
#pragma unroll
        for (int i = 0; i < 16; ++i) { o0[i] = 0.f; o1[i] = 0.f; }
#pragma unroll
        for (int s = 0; s < 4; ++s) { const bf16x8 sa = *(const bf16x8*)(sbase + (32 * dvt + r) * 64 + 16 * s + 8 * h); o0 = MFMA32(sa, qt[0][s], o0); o1 = MFMA32(sa, qt[1][s], o1); }
#pragma unroll
        for (int jt = 0; jt < 2; ++jt)
#pragma unroll
            for (int s2 = 0; s2 < 2; ++s2) {
                const bf16_t* vp = vbase + (size_t)(32 * dvt + r) * SEQ + 32 * jt + 16 * s2 + 4 * h;
                const s16x4 lo = *(const s16x4*)vp, hi = *(const s16x4*)(vp + 8);
                bf16x8 vf; vf[0] = lo[0]; vf[1] = lo[1]; vf[2] = lo[2]; vf[3] = lo[3]; vf[4] = hi[0]; vf[5] = hi[1]; vf[6] = hi[2]; vf[7] = hi[3];
                if (jt == 0) { o0 = MFMA32(vf, p00[s2], o0); o1 = MFMA32(vf, p01[s2], o1); } else o1 = MFMA32(vf, p11[s2], o1);
            }
#pragma unroll
        for (int i = 0; i < 16; ++i) { ss0 += o0[i] * o0[i]; ss1 += o1[i] * o1[i]; }
#pragma unroll
        for (int g = 0; g < 4; ++g) { u32x2 w0, w1; w0.x = pk2(o0[4 * g], o0[4 * g + 1]); w0.y = pk2(o0[4 * g + 2], o0[4 * g + 3]); w1.x = pk2(o1[4 * g], o1[4 * g + 1]); w1.y = pk2(o1[4 * g + 2], o1[4 * g + 3]);
            *(LAS u32x2*)(wl + r * GB_P + (32 * dvt + 8 * g + 4 * h) * 2) = w0; *(LAS u32x2*)(wl + (32 + r) * GB_P + (32 * dvt + 8 * g + 4 * h) * 2) = w1; }
    }
    ss0 += __shfl_xor(ss0, 32); ss1 += __shfl_xor(ss1, 32);
    LAS float* rsv = (LAS float*)(wl + 64 * GB_P);
    if (h == 0) { rsv[r] = rsqrtf(ss0 * (1.f / 128.f) + EPS); rsv[32 + r] = rsqrtf(ss1 * (1.f / 128.f) + EPS); }
#pragma unroll 4
    for (int k = 0; k < 16; ++k) { const int p = lane + 64 * k, tok = p >> 4, pc = p & 15;
        const u32x4 ow = *(const LAS u32x4*)(wl + tok * GB_P + pc * 16); const float rs = rsv[tok];
        const f32x4 g0 = *(const f32x4*)(ggla + hb * 128 + 8 * pc), g1 = *(const f32x4*)(ggla + hb * 128 + 8 * pc + 4);
        const u32x4 gw = *(const u32x4*)(RS + (row0 + tok) * 512 + hb * 128 + 8 * pc);
        u32x4 yo;
        yo.x = pk2(bf2f(ow.x & 0xffffu) * rs * g0[0] * bf2f(gw.x & 0xffffu), bf2f(ow.x >> 16) * rs * g0[1] * bf2f(gw.x >> 16));
        yo.y = pk2(bf2f(ow.y & 0xffffu) * rs * g0[2] * bf2f(gw.y & 0xffffu), bf2f(ow.y >> 16) * rs * g0[3] * bf2f(gw.y >> 16));
        yo.z = pk2(bf2f(ow.z & 0xffffu) * rs * g1[0] * bf2f(gw.z & 0xffffu), bf2f(ow.z >> 16) * rs * g1[1] * bf2f(gw.z >> 16));
        yo.w = pk2(bf2f(ow.w & 0xffffu) * rs * g1[2] * bf2f(gw.w & 0xffffu), bf2f(ow.w >> 16) * rs * g1[3] * bf2f(gw.w >> 16));
        *(u32x4*)(Y + (row0 + tok) * 1024 + 512 + hb * 128 + 8 * pc) = yo; }
}

__device__ __forceinline__ void gla_sample_unit(LAS unsigned char* lds, const float* LA, const bf16_t* QB, const bf16_t* KB, const bf16_t* VB, const bf16_t* RS,
                                                const float* S0, const float* ggla, bf16_t* Y, float* Sout, int b, int hb, int tid) {
    LAS float* q = (LAS float*)lds; LAS float* k = q + 2048; LAS float* a = k + 2048; LAS float* v = a + 2048; LAS float* part = v + 4096; LAS float* O = part + 512;
    const size_t row0 = (size_t)MP + (size_t)b * TS;
#pragma unroll
    for (int i = 0; i < 4; ++i) { const int idx = tid + 512 * i, t = idx >> 6, dk = idx & 63;
        q[idx] = bf2f(QB[(row0 + t) * 256 + hb * 64 + dk]); k[idx] = bf2f(KB[(row0 + t) * 256 + hb * 64 + dk]); a[idx] = __expf(LA[((size_t)b * TS + t) * 256 + hb * 64 + dk]); }
#pragma unroll
    for (int i = 0; i < 8; ++i) { const int idx = tid + 512 * i, t = idx >> 7, dv = idx & 127; v[idx] = bf2f(VB[((size_t)b * TS + t) * 512 + hb * 128 + dv]); }
    const int dv = tid & 127, g = tid >> 7;
    float S[16];
    const float* s0 = S0 + (size_t)(b * 4 + hb) * 8192;
#pragma unroll
    for (int i = 0; i < 16; ++i) S[i] = s0[(16 * g + i) * 128 + dv];
    __syncthreads();
    for (int t = 0; t < TS; ++t) {
        const float vv = v[t * 128 + dv]; float p = 0.f;
#pragma unroll
        for (int i = 0; i < 16; ++i) { const int dk = 16 * g + i; S[i] = a[t * 64 + dk] * S[i] + k[t * 64 + dk] * vv; p += q[t * 64 + dk] * S[i]; }
        part[g * 128 + dv] = p;
        __syncthreads();
        if (tid < 128) O[t * 128 + tid] = (part[tid] + part[128 + tid]) + (part[256 + tid] + part[384 + tid]);
        __syncthreads();
    }
    float* so = Sout + (size_t)(b * 4 + hb) * 8192;
#pragma unroll
    for (int i = 0; i < 16; ++i) so[(16 * g + i) * 128 + dv] = S[i];
    { const int lane = tid & 63, wave = tid >> 6;
#pragma unroll
      for (int tt = 0; tt < 4; ++tt) { const int t = 4 * wave + tt; const float o0 = O[t * 128 + lane], o1 = O[t * 128 + 64 + lane];
          const float rs = rsqrtf(wave_sum(o0 * o0 + o1 * o1) * (1.f / 128.f) + EPS);
          Y[(row0 + t) * 1024 + 512 + hb * 128 + lane] = f2bf(o0 * rs * ggla[hb * 128 + lane] * bf2f(RS[(row0 + t) * 512 + hb * 128 + lane]));
          Y[(row0 + t) * 1024 + 512 + hb * 128 + 64 + lane] = f2bf(o1 * rs * ggla[hb * 128 + 64 + lane] * bf2f(RS[(row0 + t) * 512 + hb * 128 + 64 + lane])); } }
    __syncthreads();
}


constexpr int MA_QP = 528, MA_QS1 = 16896, MA_PS = 33792, MA_MX = 50688, MA_SUM = 51712, MA_OS = 52736;
__device__ __forceinline__ void mem_attn_item(LAS unsigned char* lds, const bf16_t* Kh, const bf16_t* VTh, const bf16_t* Qh, bf16_t* Oh, int ntiles, int tid) {
    const int lane = tid & 63, wave = tid >> 6, r = lane & 31, h = lane >> 5;
    LAS unsigned char* Ps = lds + MA_PS; LAS float* MX = (LAS float*)(lds + MA_MX); LAS float* SUM = (LAS float*)(lds + MA_SUM);
    bf16x8 kf[16], vf[16];
#pragma unroll
    for (int s = 0; s < 16; ++s) kf[s] = *(const bf16x8*)(Kh + (size_t)(32 * wave + r) * 1024 + 16 * s + 8 * h);
#pragma unroll
    for (int s = 0; s < 16; ++s) vf[s] = *(const bf16x8*)(VTh + (size_t)(32 * wave + r) * 256 + 16 * s + 8 * h);
    const int q0 = tid >> 5, c0 = tid & 31;
    u32x4 qreg[2];
    qreg[0] = *(const u32x4*)(Qh + (size_t)q0 * 1024 + 8 * c0); qreg[1] = *(const u32x4*)(Qh + (size_t)(q0 + 16) * 1024 + 8 * c0);
    *(LAS u32x4*)(lds + q0 * MA_QP + 16 * c0) = qreg[0]; *(LAS u32x4*)(lds + (q0 + 16) * MA_QP + 16 * c0) = qreg[1];
    for (int t = 0; t < ntiles; ++t) {
        const LAS unsigned char* cur = lds + ((t & 1) ? MA_QS1 : 0); LAS unsigned char* nxt = lds + ((t & 1) ? 0 : MA_QS1);
        const bool more = t + 1 < ntiles;
        if (more) { const bf16_t* qn = Qh + (size_t)(32 * (t + 1)) * 1024;
            qreg[0] = *(const u32x4*)(qn + (size_t)q0 * 1024 + 8 * c0); qreg[1] = *(const u32x4*)(qn + (size_t)(q0 + 16) * 1024 + 8 * c0); }
        if (t == 0) __syncthreads();
        f32x16 sacc, sacb;
#pragma unroll
        for (int i = 0; i < 16; ++i) { sacc[i] = 0.f; sacb[i] = 0.f; }
#pragma unroll
        for (int s = 0; s < 16; s += 2) {
            sacc = MFMA32(kf[s], *(const LAS bf16x8*)(cur + r * MA_QP + (16 * s + 8 * h) * 2), sacc);
            sacb = MFMA32(kf[s + 1], *(const LAS bf16x8*)(cur + r * MA_QP + (16 * (s + 1) + 8 * h) * 2), sacb); }
#pragma unroll
        for (int i = 0; i < 16; ++i) sacc[i] += sacb[i];
        float mx = sacc[0];
#pragma unroll
        for (int i = 1; i < 16; ++i) mx = fmaxf(mx, sacc[i]);
        mx = fmaxf(mx, __shfl_xor(mx, 32));
        if (h == 0) MX[wave * 32 + r] = mx;
        __syncthreads();
        float m = MX[r];
#pragma unroll
        for (int w = 1; w < 8; ++w) m = fmaxf(m, MX[w * 32 + r]);
        float ps = 0.f;
#pragma unroll
        for (int i = 0; i < 16; ++i) { const float p = __builtin_amdgcn_exp2f(sacc[i] - m); sacc[i] = p; ps += p; }
        ps += __shfl_xor(ps, 32);
        if (h == 0) SUM[wave * 32 + r] = ps;
#pragma unroll
        for (int g = 0; g < 4; ++g) { u32x2 w2; w2.x = pk2(sacc[4 * g], sacc[4 * g + 1]); w2.y = pk2(sacc[4 * g + 2], sacc[4 * g + 3]);
            *(LAS u32x2*)(Ps + r * MA_QP + (32 * wave + 8 * g + 4 * h) * 2) = w2; }
        if (more) { *(LAS u32x4*)(nxt + q0 * MA_QP + 16 * c0) = qreg[0]; *(LAS u32x4*)(nxt + (q0 + 16) * MA_QP + 16 * c0) = qreg[1]; }
        if (t > 0) {
            bf16_t* op = Oh + (size_t)(32 * (t - 1)) * 1024;
            *(u32x4*)(op + (size_t)q0 * 1024 + 8 * c0) = *(const LAS u32x4*)(lds + MA_OS + q0 * MA_QP + 16 * c0);
            *(u32x4*)(op + (size_t)(q0 + 16) * 1024 + 8 * c0) = *(const LAS u32x4*)(lds + MA_OS + (q0 + 16) * MA_QP + 16 * c0); }
        __syncthreads();
        f32x16 o, ob;
#pragma unroll
        for (int i = 0; i < 16; ++i) { o[i] = 0.f; ob[i] = 0.f; }
#pragma unroll
        for (int s = 0; s < 16; s += 2) {
            o = MFMA32(vf[s], *(const LAS bf16x8*)(Ps + r * MA_QP + (16 * s + 8 * h) * 2), o);
            ob = MFMA32(vf[s + 1], *(const LAS bf16x8*)(Ps + r * MA_QP + (16 * (s + 1) + 8 * h) * 2), ob); }
#pragma unroll
        for (int i = 0; i < 16; ++i) o[i] += ob[i];
        float l = SUM[r];
#pragma unroll
        for (int w = 1; w < 8; ++w) l += SUM[w * 32 + r];
        const float inv = 1.f / l;
#pragma unroll
        for (int g = 0; g < 4; ++g) { u32x2 w2; w2.x = pk2(o[4 * g] * inv, o[4 * g + 1] * inv); w2.y = pk2(o[4 * g + 2] * inv, o[4 * g + 3] * inv);
            *(LAS u32x2*)(lds + MA_OS + r * MA_QP + (32 * wave + 8 * g + 4 * h) * 2) = w2; }
    }
    __syncthreads();
    { bf16_t* op = Oh + (size_t)(32 * (ntiles - 1)) * 1024;
      *(u32x4*)(op + (size_t)q0 * 1024 + 8 * c0) = *(const LAS u32x4*)(lds + MA_OS + q0 * MA_QP + 16 * c0);
      *(u32x4*)(op + (size_t)(q0 + 16) * 1024 + 8 * c0) = *(const LAS u32x4*)(lds + MA_OS + (q0 + 16) * MA_QP + 16 * c0); }
    __syncthreads();
}

__device__ __forceinline__ void small_gemm(LAS unsigned char* lds, const bf16_t* A, const bf16_t* Bt, bf16_t* O, int K, float scale, int bx, int G, int tid) {
    LAS float* red = (LAS float*)lds;
    const int lane = tid & 63, wave = tid >> 6, r = lane & 31, h = lane >> 5;
    const int kw = K / 8, nch = kw / 32;
    LAS unsigned char* sl = lds + 65536 + wave * 7680;
    const int lr = lane >> 2, lp = lane & 3;
    for (int tile = bx; tile < 256; tile += G) {
        const int row0 = (tile >> 5) * 64, col0 = (tile & 31) * 32;
        const bf16_t* ap = A + (size_t)(row0 + lr) * K + wave * kw + 8 * lp;
        const bf16_t* bp = Bt + (size_t)(col0 + lr) * K + wave * kw + 8 * lp;
        u32x4 ar[4], br[2];
#pragma unroll
        for (int i = 0; i < 4; ++i) ar[i] = *(const u32x4*)(ap + (size_t)(16 * i) * K);
#pragma unroll
        for (int i = 0; i < 2; ++i) br[i] = *(const u32x4*)(bp + (size_t)(16 * i) * K);
        f32x16 acc0, acc1;
#pragma unroll
        for (int i = 0; i < 16; ++i) { acc0[i] = 0.f; acc1[i] = 0.f; }
        for (int ch = 0; ch < nch; ++ch) {
#pragma unroll
            for (int i = 0; i < 4; ++i) *(LAS u32x4*)(sl + (lr + 16 * i) * 80 + 16 * lp) = ar[i];
#pragma unroll
            for (int i = 0; i < 2; ++i) *(LAS u32x4*)(sl + 5120 + (lr + 16 * i) * 80 + 16 * lp) = br[i];
            if (ch + 1 < nch) {
#pragma unroll
                for (int i = 0; i < 4; ++i) ar[i] = *(const u32x4*)(ap + (size_t)(16 * i) * K + 32 * (ch + 1));
#pragma unroll
                for (int i = 0; i < 2; ++i) br[i] = *(const u32x4*)(bp + (size_t)(16 * i) * K + 32 * (ch + 1));
            }
#pragma unroll
            for (int ks = 0; ks < 2; ++ks) {
                const bf16x8 fb = *(const LAS bf16x8*)(sl + 5120 + r * 80 + (16 * ks + 8 * h) * 2);
                acc0 = MFMA32(*(const LAS bf16x8*)(sl + r * 80 + (16 * ks + 8 * h) * 2), fb, acc0);
                acc1 = MFMA32(*(const LAS bf16x8*)(sl + (32 + r) * 80 + (16 * ks + 8 * h) * 2), fb, acc1);
            }
        }
#pragma unroll
        for (int i = 0; i < 16; ++i) { red[((wave * 2 + 0) * 16 + i) * 64 + lane] = acc0[i]; red[((wave * 2 + 1) * 16 + i) * 64 + lane] = acc1[i]; }
        __syncthreads();
#pragma unroll
        for (int j = 0; j < 4; ++j) { const int e = tid + 512 * j, le = e & 63, ie = (e >> 6) & 15, mh = e >> 10; float sum = 0.f;
#pragma unroll
            for (int w = 0; w < 8; ++w) sum += red[((w * 2 + mh) * 16 + ie) * 64 + le];
            O[(size_t)(row0 + 32 * mh + crow(ie, le >> 5)) * 1024 + col0 + (le & 31)] = f2bf(sum * scale); }
        __syncthreads();
    }
}
#define XB_TMO      128
#define XB_XCNT(j)  (256  + 64 * (j))
#define XB_XSUB(j)  (1280 + 64 * (j))
#define XB_XGEN(j)  (2304 + 64 * (j))
#define XB_TOP      3328
#define XB_TOPGEN   3392
#define XCD_BAR_WORDS 3456
#define XB_SPIN_CAP (1u << 18)

__device__ __forceinline__ unsigned xb_ld(unsigned* p)              { return __hip_atomic_load(p, __ATOMIC_RELAXED, __HIP_MEMORY_SCOPE_AGENT); }
__device__ __forceinline__ unsigned xb_add(unsigned* p, unsigned v) { return __hip_atomic_fetch_add(p, v, __ATOMIC_RELAXED, __HIP_MEMORY_SCOPE_AGENT); }
__device__ __forceinline__ unsigned xb_xcc_id() { return (unsigned)__builtin_amdgcn_s_getreg((3 << 11) | 20) & 0xFu; }
#define XB_SPIN(cond, bar) do { unsigned _sp = 0; while (cond) { __builtin_amdgcn_s_sleep(1); \
    if ((++_sp & 255u) == 0u) { if (xb_ld(&(bar)[XB_TMO])) break; if (_sp > XB_SPIN_CAP) { atomicAdd(&(bar)[XB_TMO], 1u); break; } } } } while (0)

struct XcdBarrier {
    unsigned* bar; unsigned x;
    volatile LAS unsigned* st;
};

__device__ __forceinline__ XcdBarrier xcd_barrier_post(unsigned* bar, volatile LAS unsigned* st) {
    XcdBarrier b; b.bar = bar; b.x = xb_xcc_id(); b.st = st;
    if (threadIdx.x == 0) (void)xb_add(&bar[XB_XCNT(b.x)], 1u);
    return b;
}
__device__ __forceinline__ void xcd_barrier_complete(unsigned* bar, unsigned x, unsigned& nloc, unsigned& nx) {
    const unsigned G = gridDim.x * gridDim.y * gridDim.z;
    unsigned sum, cnt, mine, sp = 0u;
    for (;;) {
        sum = 0u; cnt = 0u; mine = 0u;
#pragma unroll
        for (unsigned j = 0; j < 16; ++j) { const unsigned c = xb_ld(&bar[XB_XCNT(j)]); sum += c; cnt += (c > 0u) ? 1u : 0u; mine = (j == x) ? c : mine; }
        if (sum == G) break;
        __builtin_amdgcn_s_sleep(1);
        if ((++sp & 255u) == 0u) { if (xb_ld(&bar[XB_TMO])) break; if (sp > XB_SPIN_CAP) { atomicAdd(&bar[XB_TMO], 1u); break; } }
    }
    nloc = mine > 0u ? mine : 1u; nx = cnt > 0u ? cnt : 1u;
}

__device__ __forceinline__ void xcd_barrier(const XcdBarrier& b) {
    asm volatile("s_waitcnt vmcnt(0)" ::: "memory");
    __syncthreads();
    if (threadIdx.x == 0) {
        unsigned* bar = b.bar;
        __builtin_amdgcn_s_waitcnt(0);
        unsigned nloc = b.st[0], nx = b.st[1];
        if (nloc == 0u) { xcd_barrier_complete(bar, b.x, nloc, nx); b.st[0] = nloc; b.st[1] = nx; }
        const unsigned old = xb_add(&bar[XB_XSUB(b.x)], 1u);
        const unsigned gen = old / nloc;
        if (old + 1u == (gen + 1u) * nloc) {
            __builtin_amdgcn_fence(__ATOMIC_RELEASE, "agent");
            asm volatile("s_waitcnt vmcnt(0)" ::: "memory");
            const unsigned og = xb_add(&bar[XB_TOP], 1u);
            const unsigned tg = og / nx;
            if (og + 1u == (tg + 1u) * nx) xb_add(&bar[XB_TOPGEN], 1u);
            else XB_SPIN(xb_ld(&bar[XB_TOPGEN]) == tg, bar);
            __builtin_amdgcn_fence(__ATOMIC_ACQUIRE, "agent");
            xb_add(&bar[XB_XGEN(b.x)], 1u);
            asm volatile("s_waitcnt vmcnt(0)" ::: "memory");
        } else {
            XB_SPIN(xb_ld(&bar[XB_XGEN(b.x)]) == gen, bar);
            __builtin_amdgcn_fence(__ATOMIC_ACQUIRE, "agent");
            asm volatile("s_waitcnt vmcnt(0)" ::: "memory");
        }
    }
    __syncthreads();
}

#ifndef PHMASK
#define PHMASK 0xFFFF
#endif
#define PH(n) (((PHMASK) >> (n)) & 1)
#ifndef DBLMASK
#define DBLMASK 0
#endif
#define NREP(n) ((((DBLMASK) >> (n)) & 1) ? 2 : 1)
__global__ void __launch_bounds__(NTHREADS) fwd_megakernel(Params P) {
    extern __shared__ __attribute__((aligned(16))) unsigned char lds_raw[];
    LAS unsigned char* lds = (LAS unsigned char*)lds_raw;
    cg::grid_group grid = cg::this_grid();
    volatile LAS unsigned* bst = (volatile LAS unsigned*)(lds + LDS_BYTES - 64);
    if (threadIdx.x < 2) bst[threadIdx.x] = 0u;
    __syncthreads();
    const XcdBarrier xbar = xcd_barrier_post((unsigned*)(P.ws + 16384), bst);
#define GRID_BAR() xcd_barrier(xbar)
    if (P.ws == nullptr) grid.sync();
    const int G = gridDim.x, bx = blockIdx.x;
    const int NGW = G * NWAVES, NGT = G * NTHREADS;
#define LOCALS int tid = threadIdx.x; asm volatile("" : "+v"(tid)); const int lane = tid & 63, wave = __builtin_amdgcn_readfirstlane(tid >> 6); \
    const int gw = bx * NWAVES + wave, gt = bx * NTHREADS + tid; (void)lane; (void)gw; (void)gt;
#define WSPTRS __attribute__((address_space(1))) unsigned char* wsg_ = (__attribute__((address_space(1))) unsigned char*)P.ws; asm volatile("" : "+s"(wsg_)); unsigned char* ws = (unsigned char*)wsg_; __attribute__((address_space(1))) float* outg_ = (__attribute__((address_space(1))) float*)P.out; asm volatile("" : "+s"(outg_)); float* out = (float*)outg_; bf16_t* WinT = (bf16_t*)(ws + WS_WIN); bf16_t* WoT = (bf16_t*)(ws + WS_WO); bf16_t* WmqT = (bf16_t*)(ws + WS_WMQ); bf16_t* WmkvT = (bf16_t*)(ws + WS_WMKV); bf16_t* WmoT = (bf16_t*)(ws + WS_WMO); bf16_t* WguT = (bf16_t*)(ws + WS_WGU); bf16_t* WdT = (bf16_t*)(ws + WS_WD); bf16_t* MN = (bf16_t*)(ws + WS_MN); bf16_t* KMP = (bf16_t*)(ws + WS_KMP); bf16_t* VMTP = (bf16_t*)(ws + WS_VMTP); bf16_t* KMS = (bf16_t*)(ws + WS_KMS); bf16_t* VMTS = (bf16_t*)(ws + WS_VMTS); bf16_t* H = (bf16_t*)(ws + WS_H); bf16_t* Y = (bf16_t*)(ws + WS_Y); bf16_t* U = (bf16_t*)(ws + WS_U); float* DS = (float*)(ws + WS_DS); float* DEC = (float*)(ws + WS_DEC); bf16_t* QA = (bf16_t*)(ws + WS_QA); bf16_t* KP = (bf16_t*)(ws + WS_KP); bf16_t* VPT = (bf16_t*)(ws + WS_VPT); bf16_t* KS = (bf16_t*)(ws + WS_KS); bf16_t* VST = (bf16_t*)(ws + WS_VST); bf16_t* QB = (bf16_t*)(ws + WS_QB); bf16_t* KB = (bf16_t*)(ws + WS_KB); bf16_t* VB = (bf16_t*)(ws + WS_VB); bf16_t* RS = (bf16_t*)(ws + WS_RS); float* LA = (float*)(ws + WS_LA); bf16_t* HID = (bf16_t*)(ws + WS_HID); bf16_t* X1 = (bf16_t*)(ws + WS_R); bf16_t* X2 = (bf16_t*)(ws + WS_Y); bf16_t* KBT = (bf16_t*)(ws + WS_KBT); bf16_t* VBS = (bf16_t*)(ws + WS_VBS); float* LAS_ = (float*)(ws + WS_LAS); float* BC = (float*)(ws + WS_BC); bf16_t* SST = (bf16_t*)(ws + WS_SST); bf16_t* BT1 = (bf16_t*)(ws + WS_BT1); bf16_t* BT2 = (bf16_t*)(ws + WS_BT2); bf16_t* WMQN = (bf16_t*)(ws + WS_WMQN); bf16_t* VMN = (bf16_t*)(ws + WS_VMN);
    for (int rep_ = 0; rep_ < NREP(0); ++rep_) {
    if constexpr (PH(0)) { WSPTRS
        LOCALS
        LAS float* scr = (LAS float*)(lds + wave * 16384);
        constexpr int C1 = 16 * 80, C2 = 16 * 16, C3 = 16 * 32, C8 = 16 * 88, C10 = 44 * 32, C11 = 128 * 16, C12 = 64 * 32;
        constexpr int NITEMS = C1 + C2 + 5 * C3 + 2 * C8 + C10 + C11 + C12;
        for (int it = gw; it < NITEMS; it += NGW) {
            int r = it;
            if (r < C1) { tr_item(P.in[I_WIN], 3088, WinT, 1024, 64 * (r / 80), 32 * (r % 80), 32 * (r % 80), scr, lane); continue; } r -= C1;
            if (r < C2) { tr_item(P.in[I_WIN] + 2576, 3088, WinT, 1024, 64 * (r / 16), 32 * (r % 16), 2560 + 32 * (r % 16), scr, lane); continue; } r -= C2;
            if (r < C3) { tr_item(P.in[I_WO], 1024, WoT, 1024, 64 * (r / 32), 32 * (r % 32), 32 * (r % 32), scr, lane); continue; } r -= C3;
            if (r < C3) { tr_item(P.in[I_WMQ], 1024, WmqT, 1024, 64 * (r / 32), 32 * (r % 32), 32 * (r % 32), scr, lane); continue; } r -= C3;
            if (r < C3) { tr_item(P.in[I_WMK], 1024, WmkvT, 1024, 64 * (r / 32), 32 * (r % 32), 32 * (r % 32), scr, lane); continue; } r -= C3;
            if (r < C3) { tr_item(P.in[I_WMV], 1024, WmkvT, 1024, 64 * (r / 32), 32 * (r % 32), 1024 + 32 * (r % 32), scr, lane); continue; } r -= C3;
            if (r < C3) { tr_item(P.in[I_WMO], 1024, WmoT, 1024, 64 * (r / 32), 32 * (r % 32), 32 * (r % 32), scr, lane); continue; } r -= C3;
            if (r < C8) { const int n0 = 32 * (r % 88); tr_item(P.in[I_WG], DFF, WguT, 1024, 64 * (r / 88), n0, (n0 >> 7) * 256 + (n0 & 127), scr, lane); continue; } r -= C8;
            if (r < C8) { const int n0 = 32 * (r % 88); tr_item(P.in[I_WU], DFF, WguT, 1024, 64 * (r / 88), n0, (n0 >> 7) * 256 + 128 + (n0 & 127), scr, lane); continue; } r -= C8;
            if (r < C10) { tr_item(P.in[I_WDN], 1024, WdT, DFF, 64 * (r / 32), 32 * (r % 32), 32 * (r % 32), scr, lane); continue; } r -= C10;
            if (r < C11) { const int bh = r >> 4, q = r & 15, b = bh >> 3, hh = bh & 7;
                tr_item(P.in[I_CAV] + (size_t)b * 512 * 512 + hh * 64, 512, VST + (size_t)bh * 64 * 544, 544, 64 * (q >> 1), 32 * (q & 1), 32 * (q & 1), scr, lane); continue; } r -= C11;
            { const int bh = r >> 5, q = r & 31, b = bh >> 2, hh = bh & 3;
                tr_item(P.in[I_CMV] + (size_t)b * 256 * 1024 + hh * 256, 1024, VMTS + (size_t)bh * 256 * 256, 256, 64 * (q >> 3), 32 * (q & 7), 32 * (q & 7), scr, lane); }
        }
        for (int idx = gt; idx < 256 * 1024; idx += NGT) { const int n = idx >> 10, k = idx & 1023; const float* wr_ = P.in[I_WIN] + (size_t)k * 3088 + 2560; const float* a2 = P.in[I_WA2] + n;
            float s = 0.f;
#pragma unroll
            for (int q4 = 0; q4 < 4; ++q4) { const f32x4 w4 = *(const f32x4*)(wr_ + 4 * q4);
                s += (w4[0] * a2[(4 * q4) * 256] + w4[1] * a2[(4 * q4 + 1) * 256]) + (w4[2] * a2[(4 * q4 + 2) * 256] + w4[3] * a2[(4 * q4 + 3) * 256]); }
            WinT[(size_t)(3072 + n) * 1024 + k] = f2bf(s); }
        for (int idx = gt; idx < 1024 * 1024 / 4; idx += NGT) st_bf4(WMQN + (size_t)idx * 4, *(const f32x4*)(P.in[I_WMQ] + (size_t)idx * 4));
        for (int idx = gt; idx < NBS * 512 * 512 / 4; idx += NGT) { const int e = idx * 4, b = e >> 18, rem = e & 262143, t = rem >> 9, c = rem & 511;
            st_bf4(KS + ((size_t)b * 544 + t) * 512 + c, __builtin_nontemporal_load((const f32x4*)(P.in[I_CAK] + e))); }
        for (int idx = gt; idx < NBS * 256 * 1024 / 4; idx += NGT) st_bf4(KMS + (size_t)idx * 4, __builtin_nontemporal_load((const f32x4*)(P.in[I_CMK] + (size_t)idx * 4)));
        f32x4 gmix[2][2], gmem[2][2];
#pragma unroll
        for (int j = 0; j < 2; ++j)
#pragma unroll
            for (int hf = 0; hf < 2; ++hf) { gmix[j][hf] = *(const f32x4*)(P.in[I_GPREMIX] + 512 * j + 8 * lane + 4 * hf); gmem[j][hf] = *(const f32x4*)(P.in[I_GMEM] + 512 * j + 8 * lane + 4 * hf); }
        { int m = gw;
          for (; m + 3 * NGW < MT; m += 4 * NGW) {
              const float* const xr[4] = {xrow_ptr(P.in[I_XP], P.in[I_XS], m), xrow_ptr(P.in[I_XP], P.in[I_XS], m + NGW), xrow_ptr(P.in[I_XP], P.in[I_XS], m + 2 * NGW), xrow_ptr(P.in[I_XP], P.in[I_XS], m + 3 * NGW)};
              bf16_t* const orw[4] = {H + (size_t)m * DM, H + (size_t)(m + NGW) * DM, H + (size_t)(m + 2 * NGW) * DM, H + (size_t)(m + 3 * NGW) * DM};
              rms_rows_bf16<4>(xr, gmix, orw, lane); }
          for (; m < MT; m += NGW) { const float* const xr[1] = {xrow_ptr(P.in[I_XP], P.in[I_XS], m)}; bf16_t* const orw[1] = {H + (size_t)m * DM}; rms_rows_bf16<1>(xr, gmix, orw, lane); } }
        for (int m = gw; m < 512; m += NGW) { const float* const xr[1] = {P.in[I_MEM] + (size_t)m * DM}; bf16_t* const orw[1] = {MN + (size_t)m * DM}; rms_rows_bf16<1>(xr, gmem, orw, lane); }
    }
    GRID_BAR();
    }

    for (int rep_ = 0; rep_ < NREP(1); ++rep_) {
    if constexpr (PH(1)) { WSPTRS
        pg8::Gemm g{H, WinT, MT, NIN, DM}; pg8::StaticOrder S; S.init(MT, NIN, G, bx);
        EpiIn E{ws, P.in[I_BA], out, lds + EPT_OFF};
        pg8::gemm_phase<EpiIn, pg8::StaticOrder, true, true>(lds, g, S, E);
        pg8::Gemm g2{MN, WmkvT, 512, 2048, DM}; pg8::StaticOrder S2; S2.init(512, 2048, G, (bx + 16) % G);
        EpiMem E2{KMP, VMTP, VMN, out};
        pg8::gemm_phase<EpiMem, pg8::StaticOrder, true, true>(lds, g2, S2, E2);
    }
    GRID_BAR();
    }

    if constexpr (PH(2)) { WSPTRS
        LOCALS
        LAS float* rtab = (LAS float*)lds;
        for (int i = tid; i < 8 * 640; i += NTHREADS) { const int hh = i / 640, x = i - hh * 640; int d = 576 - x; d = d < -256 ? -256 : (d > 256 ? 256 : d);
            rtab[i] = P.in[I_RELB][hh * 513 + d + 256] * LOG2E; }
        __syncthreads();
        const LAS float* rv = rtab + wave * 640; LAS unsigned char* wl = lds + BA_TAB + wave * BA_WAVE;
        for (int rep_ = 0; rep_ < NREP(2); ++rep_)
        for (int k = bx >> 3; k < 64; k += (G >> 3)) {
            const int u = (bx & 7) * 64 + k; const int b = u >> 8, nc = u & 255; const int j0 = (nc < 8 ? (8 - nc) : 0) * 64;
            const long kbase = (long)b * SEQ + (long)(nc - 8) * 64; const size_t qrow = (size_t)b * SEQ + nc * 64;
            band_core64(QA + qrow * 512 + wave * 64, KP + kbase * 512 + wave * 64, 512, VPT + ((long)(b * 8 + wave) * 64) * SEQ + (long)(nc - 8) * 64, SEQ, j0, 576,
                        rv, Y + qrow * 1024 + wave * 64, wl, lane);
        }
        __syncthreads();
        for (int rep_ = 0; rep_ < NREP(14); ++rep_)
        for (int u = gw; u < NBP * NCH * 4; u += NGW) gla_wave_a(lds + wave * GA_WAVE, LA, KBT, VB, BC, DS, DEC, u, lane);
    }
    GRID_BAR();

    for (int rep_ = 0; rep_ < NREP(3); ++rep_) {
    if constexpr (PH(3)) { WSPTRS LOCALS
      if (bx < 128) {
        const int g = bx * 512 + tid;
        if (g < 8 * 8192) { const int seq = g >> 13, e = g & 8191, dk = e & 63, dv = e >> 6; float S = 0.f;
            const float* ds = DS + (size_t)seq * NCH * 8192 + e; const float* dc = DEC + (size_t)seq * NCH * 64 + dk; bf16_t* st = SST + (size_t)seq * NCH * 8192 + e;
            for (int c0 = 0; c0 < NCH; c0 += 32) { float dvv[32], de[32];
#pragma unroll
                for (int i = 0; i < 32; ++i) { dvv[i] = __builtin_nontemporal_load(ds + (size_t)(c0 + i) * 8192); de[i] = dc[(c0 + i) * 64]; }
#pragma unroll
                for (int i = 0; i < 32; ++i) { st[(size_t)(c0 + i) * 8192] = f2bf(S); S = de[i] * S + dvv[i]; } }
            out[OUT_PGLA + (size_t)seq * 8192 + dk * 128 + dv] = S; }

      } else if (bx < 128 + NBS) {
        LAS float* rtab = (LAS float*)lds;
        for (int i = tid; i < 8 * 640; i += NTHREADS) { const int hh = i / 640, x = i - hh * 640; int d = 576 - x; d = d < -256 ? -256 : (d > 256 ? 256 : d);
            rtab[i] = P.in[I_RELB][hh * 513 + d + 256] * LOG2E; }
        __syncthreads();
        const int b = bx - 128; const size_t qrow = (size_t)MP + b * TS;
        band_core(QA + qrow * 512 + wave * 64, KS + (size_t)b * 544 * 512 + wave * 64, 512, VST + ((size_t)(b * 8 + wave) * 64) * 544, 544, 0, 544,
                  rtab + wave * 640, 512, Y + qrow * 1024 + wave * 64, lds + BA_TAB + wave * BA_WAVE, lane);
      } else if (bx >= G - 64) { const int u = G - 1 - bx; gla_sample_unit(lds, LAS_, QB, KB, VBS, RS, P.in[I_SGLA], P.in[I_GGLA], Y, out + OUT_SGLA, u >> 2, u & 3, tid); }
    }
    GRID_BAR();
    }

    for (int rep_ = 0; rep_ < NREP(4); ++rep_) {
    if constexpr (PH(4)) { WSPTRS LOCALS for (int u = gw; u < NBP * NCH * 4; u += NGW) gla_wave_b(lds + wave * GB_WAVE, BC, QB, KB, VB, SST, RS, P.in[I_GGLA], Y, u, lane);
        for (int t = gw; t < 4096; t += NGW) { const int job = t >> 11, tt = t & 2047, nh = tt >> 8, n = nh >> 2, hh = nh & 3, ti = tt & 255;
            if (job == 0) { const int kt = ti >> 5, ct = ti & 31;
                pre_tile(KMP + ((size_t)n * 256 + 32 * kt) * 1024 + hh * 256, 1024, WMQN + (size_t)(32 * ct) * 1024 + hh * 256, 1024, BT1 + ((size_t)(n * 4 + hh) * 256 + 32 * kt) * 1024 + 32 * ct, 1024, 0.0625f * LOG2E, lane); }
            else { const int ct = ti >> 3, kt = ti & 7;
                pre_tile(WmoT + (size_t)(32 * ct) * 1024 + hh * 256, 1024, VMN + ((size_t)n * 256 + 32 * kt) * 1024 + hh * 256, 1024, BT2 + ((size_t)n * 1024 + 32 * ct) * 1024 + hh * 256 + 32 * kt, 1024, 1.f, lane); } }
    }
    GRID_BAR();
    }

    for (int rep_ = 0; rep_ < NREP(5); ++rep_) {
    if constexpr (PH(5)) { WSPTRS pg8::Gemm g{Y, WoT, MP, DM, DM}; pg8::StaticOrder S; S.init(MP, DM, G, bx); EpiPlain E{U, DM, 1.f};
      pg8::gemm_phase<EpiPlain, pg8::StaticOrder, true, true>(lds, g, S, E);
      LOCALS small_gemm(lds, Y + (size_t)MP * DM, WoT, U + (size_t)MP * DM, DM, 1.f, bx, G, tid); }
    GRID_BAR();
    }
    for (int rep_ = 0; rep_ < NREP(6); ++rep_) {
    if constexpr (PH(6)) { WSPTRS LOCALS
        int m = gw; const RowGains RG = load_gains(P.in[I_GPOSTMIX], P.in[I_GPREMEM], lane);
        for (; m + 3 * NGW < MT; m += 4 * NGW) { const bf16_t* const ur[4] = {U + (size_t)(m) * DM, U + (size_t)(m + 1 * NGW) * DM, U + (size_t)(m + 2 * NGW) * DM, U + (size_t)(m + 3 * NGW) * DM}; const void* const xi[4] = {(const void*)xrow_ptr(P.in[I_XP], P.in[I_XS], m), (const void*)xrow_ptr(P.in[I_XP], P.in[I_XS], m + 1 * NGW), (const void*)xrow_ptr(P.in[I_XP], P.in[I_XS], m + 2 * NGW), (const void*)xrow_ptr(P.in[I_XP], P.in[I_XS], m + 3 * NGW)};
            void* const xo[4] = {(void*)(X1 + (size_t)(m) * DM), (void*)(X1 + (size_t)(m + 1 * NGW) * DM), (void*)(X1 + (size_t)(m + 2 * NGW) * DM), (void*)(X1 + (size_t)(m + 3 * NGW) * DM)}; bf16_t* const ho[4] = {H + (size_t)(m) * DM, H + (size_t)(m + 1 * NGW) * DM, H + (size_t)(m + 2 * NGW) * DM, H + (size_t)(m + 3 * NGW) * DM};
            rowpass_rows<4, false, true>(ur, xi, RG, xo, ho, lane); }
        for (; m < MT; m += NGW) { const bf16_t* const ur[1] = {U + (size_t)(m) * DM}; const void* const xi[1] = {(const void*)xrow_ptr(P.in[I_XP], P.in[I_XS], m)}; void* const xo[1] = {(void*)(X1 + (size_t)(m) * DM)}; bf16_t* const ho[1] = {H + (size_t)(m) * DM};
            rowpass_rows<1, false, true>(ur, xi, RG, xo, ho, lane); } }
    GRID_BAR();
    }
    for (int rep_ = 0; rep_ < NREP(7); ++rep_) {
    if constexpr (PH(7)) { WSPTRS pg8::Gemm g{H, BT1, MP, DM, DM}; OrderMem S; S.S.init(MP, DM, G, bx); EpiSoftmax E{U, lds + EPT_OFF};
      pg8::gemm_phase<EpiSoftmax, OrderMem, true, true>(lds, g, S, E);
      LOCALS small_gemm(lds, H + (size_t)MP * DM, WmqT, U + (size_t)MP * DM, DM, 0.0625f * LOG2E, bx, G, tid); }
    GRID_BAR();
    }
    for (int rep_ = 0; rep_ < NREP(8); ++rep_) {
    if constexpr (PH(8)) { WSPTRS LOCALS
        for (int item = bx; item < NBS * 4; item += G) {
            const int b = item >> 2, hh = item & 3; const size_t row0 = (size_t)MP + (size_t)b * TS;
            mem_attn_item(lds, KMS + (size_t)b * 256 * 1024 + hh * 256, VMTS + (size_t)(b * 4 + hh) * 65536, U + row0 * 1024 + hh * 256, Y + row0 * 1024 + hh * 256, 1, tid);
        }
    }
    GRID_BAR();
    }
    for (int rep_ = 0; rep_ < NREP(9); ++rep_) {
    if constexpr (PH(9)) { WSPTRS pg8::Gemm g{U, BT2, MP, DM, DM}; OrderMem S; S.S.init(MP, DM, G, bx); EpiPlainM E{Y};
      pg8::gemm_phase<EpiPlainM, OrderMem, true, true>(lds, g, S, E);
      LOCALS small_gemm(lds, Y + (size_t)MP * DM, WmoT, U + (size_t)MP * DM, DM, 1.f, bx, G, tid); }
    GRID_BAR();
    }
    if constexpr (PH(10)) { WSPTRS LOCALS
        int m = gw; const RowGains RG = load_gains(P.in[I_GPOSTMEM], P.in[I_GPREFFN], lane);
        for (; m + 3 * NGW < MT; m += 4 * NGW) { const bf16_t* const ur[4] = {((m) < MP ? Y : U) + (size_t)(m) * DM, ((m + 1 * NGW) < MP ? Y : U) + (size_t)(m + 1 * NGW) * DM, ((m + 2 * NGW) < MP ? Y : U) + (size_t)(m + 2 * NGW) * DM, ((m + 3 * NGW) < MP ? Y : U) + (size_t)(m + 3 * NGW) * DM}; const void* const xi[4] = {(const void*)(X1 + (size_t)(m) * DM), (const void*)(X1 + (size_t)(m + 1 * NGW) * DM), (const void*)(X1 + (size_t)(m + 2 * NGW) * DM), (const void*)(X1 + (size_t)(m + 3 * NGW) * DM)};
            void* const xo[4] = {(void*)(X2 + (size_t)(m) * DM), (void*)(X2 + (size_t)(m + 1 * NGW) * DM), (void*)(X2 + (size_t)(m + 2 * NGW) * DM), (void*)(X2 + (size_t)(m + 3 * NGW) * DM)}; bf16_t* const ho[4] = {H + (size_t)(m) * DM, H + (size_t)(m + 1 * NGW) * DM, H + (size_t)(m + 2 * NGW) * DM, H + (size_t)(m + 3 * NGW) * DM};
            rowpass_rows<4, true, true>(ur, xi, RG, xo, ho, lane); }
        for (; m < MT; m += NGW) { const bf16_t* const ur[1] = {((m) < MP ? Y : U) + (size_t)(m) * DM}; const void* const xi[1] = {(const void*)(X1 + (size_t)(m) * DM)}; void* const xo[1] = {(void*)(X2 + (size_t)(m) * DM)}; bf16_t* const ho[1] = {H + (size_t)(m) * DM};
            rowpass_rows<1, true, true>(ur, xi, RG, xo, ho, lane); } }
    GRID_BAR();
    for (int rep_ = 0; rep_ < NREP(11); ++rep_) {
    if constexpr (PH(11)) { WSPTRS pg8::Gemm g{H, WguT, MT, 2 * DFF, DM}; pg8::StaticOrder S; S.init(MT, 2 * DFF, G, bx); EpiSwiglu E{HID};
      pg8::gemm_phase<EpiSwiglu, pg8::StaticOrder, true, true>(lds, g, S, E); }
    GRID_BAR();
    }
    for (int rep_ = 0; rep_ < NREP(12); ++rep_) {
    if constexpr (PH(12)) { WSPTRS pg8::Gemm g{HID, WdT, MP, DM, DFF}; pg8::StaticOrder S; S.init(MP, DM, G, bx); EpiPlain E{U, DM, 1.f};
      pg8::gemm_phase<EpiPlain, pg8::StaticOrder, true, true>(lds, g, S, E);
      LOCALS small_gemm(lds, HID + (size_t)MP * DFF, WdT, U + (size_t)MP * DM, DFF, 1.f, bx, G, tid); }
    GRID_BAR();
    }
    if constexpr (PH(13)) { WSPTRS LOCALS
        int m = gw; const RowGains RG = load_gains(P.in[I_GPOSTFFN], (const float*)nullptr, lane);
        for (; m + 3 * NGW < MT; m += 4 * NGW) { const bf16_t* const ur[4] = {U + (size_t)(m) * DM, U + (size_t)(m + 1 * NGW) * DM, U + (size_t)(m + 2 * NGW) * DM, U + (size_t)(m + 3 * NGW) * DM}; const void* const xi[4] = {(const void*)(X2 + (size_t)(m) * DM), (const void*)(X2 + (size_t)(m + 1 * NGW) * DM), (const void*)(X2 + (size_t)(m + 2 * NGW) * DM), (const void*)(X2 + (size_t)(m + 3 * NGW) * DM)};
            void* const xo[4] = {(void*)(out + (size_t)(m) * DM), (void*)(out + (size_t)(m + 1 * NGW) * DM), (void*)(out + (size_t)(m + 2 * NGW) * DM), (void*)(out + (size_t)(m + 3 * NGW) * DM)}; bf16_t* const ho[4] = {H + (size_t)(m) * DM, H + (size_t)(m + 1 * NGW) * DM, H + (size_t)(m + 2 * NGW) * DM, H + (size_t)(m + 3 * NGW) * DM};
            rowpass_rows<4, true, false>(ur, xi, RG, xo, ho, lane); }
        for (; m < MT; m += NGW) { const bf16_t* const ur[1] = {U + (size_t)(m) * DM}; const void* const xi[1] = {(const void*)(X2 + (size_t)(m) * DM)}; void* const xo[1] = {(void*)(out + (size_t)(m) * DM)}; bf16_t* const ho[1] = {H + (size_t)(m) * DM};
            rowpass_rows<1, true, false>(ur, xi, RG, xo, ho, lane); } }
}

extern "C" void kernel_launch(void* const* d_in, const int* in_sizes, int n_in, void* d_out, int out_size, void* d_ws, size_t ws_size, hipStream_t stream) {
    static int grid = 0;
    if (grid == 0) {
        if (n_in != 28 || (size_t)out_size != OUT_TOTAL || ws_size < WS_END) { fprintf(stderr, "kernel_launch: unexpected problem shape (n_in %d, out %d, ws %zu)\n", n_in, out_size, ws_size); grid = -1; return; }
        int dev = 0, cus = 0, per_cu = 0;
        hipGetDevice(&dev); hipDeviceGetAttribute(&cus, hipDeviceAttributeMultiprocessorCount, dev);
        hipFuncSetAttribute((const void*)fwd_megakernel, hipFuncAttributeMaxDynamicSharedMemorySize, LDS_BYTES);
        hipOccupancyMaxActiveBlocksPerMultiprocessor(&per_cu, (const void*)fwd_megakernel, NTHREADS, LDS_BYTES);
        if (per_cu < 1) { fprintf(stderr, "kernel_launch: occupancy query reports %d blocks per CU\n", per_cu); per_cu = 1; }
        grid = cus;
    }
    if (grid < 0) return;
    if (hipMemsetAsync(d_ws, 0, 65536, stream) != hipSuccess) { fprintf(stderr, "kernel_launch: memset of the barrier words failed\n"); return; }
    Params p{};
    for (int i = 0; i < 28; ++i) p.in[i] = (const float*)d_in[i];
    p.out = (float*)d_out; p.ws = (unsigned char*)d_ws;
    void* args[] = {&p};
    hipError_t e = hipLaunchCooperativeKernel((const void*)fwd_megakernel, dim3(grid), dim3(NTHREADS), args, LDS_BYTES, stream);
    if (e != hipSuccess) fprintf(stderr, "cooperative launch failed: %s (grid %d)\n", hipGetErrorString(e), grid);
}
```

```cpp
#include <hip/hip_runtime.h>
#include <hip/hip_cooperative_groups.h>
#include <cstdio>
#include <cstdint>
namespace cg = cooperative_groups;
namespace pg8 {
#define PG8_LAS __attribute__((address_space(3)))
typedef unsigned short bf16_t;
typedef short bf16x8 __attribute__((ext_vector_type(8)));
typedef float f32x4 __attribute__((ext_vector_type(4)));
typedef unsigned u32x4 __attribute__((ext_vector_type(4)));
constexpr int BM = 256, BK = 64, HALF = 128, HTB = HALF * BK * 2  , STAGE_BYTES = 8 * HTB, NXCD = 8, WGM = 8;

__host__ __device__ __forceinline__ int lds_byte(int r, int c) { const int st = (r >> 4) * 2 + (c >> 5), rr = r & 15, cc = c & 31, ob = rr * 64 + cc * 2; return st * 1024 + (ob ^ (((ob >> 9) & 1) << 5)); }
__host__ __device__ __forceinline__ void stage_rc(int b, int& R, int& C) { const int st = b / 1024, sb = b % 1024, swz = sb ^ (((sb >> 9) & 1) << 5); R = (st >> 1) * 16 + swz / 64; C = (st & 1) * 32 + (swz % 64) / 2; }
__host__ __device__ __forceinline__ int perm32(int rho) { const int n = rho >> 4, i = rho & 15; return 8 * (i >> 2) + 4 * n + (i & 3); }

struct Unit { int pm, pn; };
struct Gemm { const bf16_t* A; const bf16_t* Bt; int M, N, K; };

struct StaticOrder {
    int nM, nN, nwg, G, c;
    __host__ __device__ void init(int M, int N, int G_, int c_) { nM = M / BM; nN = N / BM; nwg = nM * nN; G = G_; c = c_; }
    __host__ __device__ bool next(int i, Unit& u) const {
        const long L = (long)i * G + c; if (L >= nwg) return false;
        int wgid = (int)L; { const int q = nwg / NXCD, r = nwg % NXCD, xcd = wgid % NXCD, off = wgid / NXCD; wgid = (xcd < r ? xcd * (q + 1) : r * (q + 1) + (xcd - r) * q) + off; }
        const int nig = WGM * nN, gid = wgid / nig, fm = gid * WGM, gsz = (nM - fm) < WGM ? (nM - fm) : WGM;
        u.pm = fm + ((wgid % nig) % gsz); u.pn = (wgid % nig) / gsz; return true;
    }
    __device__ __forceinline__ void a_ready(const Unit&) const {}
    __device__ __forceinline__ void done(const Unit&) const {}
};

__device__ __forceinline__ unsigned cvt_pk_bf16(float lo, float hi) { unsigned r; asm volatile("v_cvt_pk_bf16_f32 %0, %1, %2" : "=v"(r) : "v"(lo), "v"(hi)); return r; }
template <class Epi, class Sched, bool ALIGN_EPI = false, bool SP2 = false>
__device__ __forceinline__ void gemm_phase(PG8_LAS unsigned char* lds, const Gemm g, const Sched& S, const Epi& E) {
    int tid_ = threadIdx.x; asm volatile("" : "+v"(tid_));
    const int tid = tid_, wid = __builtin_amdgcn_readfirstlane(tid >> 6), lane = tid & 63, wr = wid >> 2, wc = wid & 3, fr = lane & 15, fq = lane >> 4;
    const int K = g.K, nt = K / BK;
    unsigned voffA[2], voffB[2];
#pragma unroll
    for (int i = 0; i < 2; ++i) { int R, C; stage_rc(tid * 16 + i * 8192, R, C); const int Rb = Epi::PERM ? ((R & ~31) + perm32(R & 31)) : R;
        voffA[i] = (unsigned)(R * K + C) * 2u; voffB[i] = (unsigned)(Rb * K + C) * 2u; }
    const size_t kstep = (size_t)(BK * 2);
    const size_t hstep = (size_t)HALF * K * 2;
    const size_t tstep = 2 * hstep;
    const unsigned ldsw = (unsigned)wid * 1024u;
    const int aoff = lds_byte(wr * 64 + fr, fq * 8), boff = lds_byte(wc * 32 + fr, fq * 8);
#define PG8_SA(b, h) (((b) * 2 + (h)) * HTB)
#define PG8_SB(b, h) ((4 + (b) * 2 + (h)) * HTB)
#define PG8_STAGE(bufoff, gbase, voff) do { _Pragma("unroll") for (int _i = 0; _i < 2; ++_i) \
        __builtin_amdgcn_global_load_lds((const unsigned*)((const char*)(gbase) + (voff)[_i]), (PG8_LAS unsigned*)(lds + (bufoff) + ldsw + _i * 8192), 16, 0, 0); } while (0)
#define PG8_LDA(dst, b, h) do { _Pragma("unroll") for (int m = 0; m < 4; ++m) _Pragma("unroll") for (int k = 0; k < 2; ++k) dst[m][k] = *(const PG8_LAS bf16x8*)(lds + PG8_SA(b, h) + aoff + m * 2048 + k * 1024); } while (0)
#define PG8_LDB(dst, b, h) do { _Pragma("unroll") for (int n = 0; n < 2; ++n) _Pragma("unroll") for (int k = 0; k < 2; ++k) dst[n][k] = *(const PG8_LAS bf16x8*)(lds + PG8_SB(b, h) + boff + n * 2048 + k * 1024); } while (0)
#define PG8_MMA(ai, bj, At, Bt) do { __builtin_amdgcn_s_setprio(1); _Pragma("unroll") for (int m = 0; m < 4; ++m) _Pragma("unroll") for (int n = 0; n < 2; ++n) _Pragma("unroll") for (int k = 0; k < 2; ++k) \
        acc[ai][bj][m][n] = __builtin_amdgcn_mfma_f32_16x16x32_bf16(Bt[n][k], At[m][k], acc[ai][bj][m][n], 0, 0, 0); __builtin_amdgcn_s_setprio(0); } while (0)
#define PG8_WAIT_V(n) asm volatile("s_waitcnt vmcnt(" #n ")" ::: "memory")
#define PG8_WAIT_L(n) asm volatile("s_waitcnt lgkmcnt(" #n ")" ::: "memory")
#define PG8_BAR __builtin_amdgcn_s_barrier()
#define PG8_SCHED __builtin_amdgcn_sched_barrier(0)
    Unit cur, nxt; int ui = 0;
    if (!S.next(0, cur)) return;
    f32x4 acc[2][2][4][2];
#pragma unroll
    for (int a = 0; a < 2; ++a)
#pragma unroll
        for (int b = 0; b < 2; ++b)
#pragma unroll
            for (int m = 0; m < 4; ++m)
#pragma unroll
                for (int n = 0; n < 2; ++n) acc[a][b][m][n] = (f32x4){0.f, 0.f, 0.f, 0.f};
    bf16x8 At[4][2], B0[2][2], B1[2][2];
    const char* cA = (const char*)g.A + (size_t)cur.pm * tstep; const char* cB = (const char*)g.Bt + (size_t)cur.pn * tstep;
    S.a_ready(cur);
    if constexpr (SP2) {
        PG8_STAGE(PG8_SB(0, 0), cB, voffB); PG8_STAGE(PG8_SB(0, 1), cB + hstep, voffB); PG8_STAGE(PG8_SA(0, 0), cA, voffA); PG8_STAGE(PG8_SA(0, 1), cA + hstep, voffA);
        if (wr == 1) PG8_BAR;
        PG8_WAIT_V(2); PG8_BAR;
        PG8_STAGE(PG8_SB(1, 0), cB + kstep, voffB); PG8_STAGE(PG8_SA(1, 0), cA + kstep, voffA); PG8_STAGE(PG8_SB(1, 1), cB + hstep + kstep, voffB);
        PG8_WAIT_V(6); PG8_BAR;
    } else {
        PG8_STAGE(PG8_SB(0, 0), cB, voffB); PG8_STAGE(PG8_SA(0, 0), cA, voffA); PG8_STAGE(PG8_SB(0, 1), cB + hstep, voffB); PG8_STAGE(PG8_SA(0, 1), cA + hstep, voffA);
        if (wr == 1) PG8_BAR;
        PG8_WAIT_V(4); PG8_BAR;
        PG8_STAGE(PG8_SB(1, 0), cB + kstep, voffB); PG8_STAGE(PG8_SA(1, 0), cA + kstep, voffA); PG8_STAGE(PG8_SB(1, 1), cB + hstep + kstep, voffB);
        PG8_WAIT_V(6); PG8_BAR;
    }
    for (;;) {
        const bool has_next = S.next(ui + 1, nxt);
        const char* nA = has_next ? (const char*)g.A + (size_t)nxt.pm * tstep : cA; const char* nB = has_next ? (const char*)g.Bt + (size_t)nxt.pn * tstep : cB;
        for (int t = 0; t < nt; t += 2) {
            const bool last = (t == nt - 2);
            const char* a1 = cA + (size_t)(t + 1) * kstep;
            const char* a2 = last ? nA : cA + (size_t)(t + 2) * kstep; const char* b2 = last ? nB : cB + (size_t)(t + 2) * kstep;
            const char* a3 = a2 + kstep; const char* b3 = b2 + kstep;
            if (last && has_next) S.a_ready(nxt);
            if constexpr (SP2) {
            PG8_LDB(B0, 0, 0); PG8_LDB(B1, 0, 1); PG8_SCHED; PG8_LDA(At, 0, 0); PG8_STAGE(PG8_SA(1, 1), a1 + hstep, voffA);
            PG8_WAIT_V(8); PG8_WAIT_L(0); PG8_BAR; PG8_MMA(0, 0, At, B0); PG8_MMA(0, 1, At, B1); PG8_BAR; PG8_SCHED;
            PG8_LDA(At, 0, 1); PG8_STAGE(PG8_SB(0, 0), b2, voffB); PG8_STAGE(PG8_SB(0, 1), b2 + hstep, voffB); PG8_STAGE(PG8_SA(0, 0), a2, voffA);
            PG8_WAIT_V(8); PG8_WAIT_L(0); PG8_BAR; PG8_MMA(1, 0, At, B0); PG8_MMA(1, 1, At, B1); PG8_BAR; PG8_SCHED;
            PG8_LDB(B0, 1, 0); PG8_LDB(B1, 1, 1); PG8_SCHED; PG8_LDA(At, 1, 0); PG8_STAGE(PG8_SA(0, 1), a2 + hstep, voffA);
            PG8_WAIT_V(8); PG8_WAIT_L(0); PG8_BAR; PG8_MMA(0, 0, At, B0); PG8_MMA(0, 1, At, B1); PG8_BAR; PG8_SCHED;
            PG8_LDA(At, 1, 1); PG8_STAGE(PG8_SB(1, 0), b3, voffB); PG8_STAGE(PG8_SB(1, 1), b3 + hstep, voffB); PG8_STAGE(PG8_SA(1, 0), a3, voffA);
            PG8_WAIT_V(8); PG8_WAIT_L(0); PG8_BAR; PG8_MMA(1, 0, At, B0); PG8_MMA(1, 1, At, B1); PG8_BAR; PG8_SCHED;
            } else {
            PG8_LDB(B0, 0, 0); PG8_SCHED; PG8_LDA(At, 0, 0); PG8_STAGE(PG8_SA(1, 1), a1 + hstep, voffA);
            PG8_WAIT_L(8); PG8_BAR; PG8_WAIT_L(0); PG8_MMA(0, 0, At, B0); PG8_BAR; PG8_SCHED;
            PG8_LDB(B1, 0, 1); PG8_STAGE(PG8_SB(0, 0), b2, voffB);
            PG8_BAR; PG8_WAIT_L(0); PG8_MMA(0, 1, At, B1); PG8_BAR;
            PG8_LDA(At, 0, 1); PG8_STAGE(PG8_SA(0, 0), a2, voffA);
            PG8_BAR; PG8_WAIT_L(0); PG8_MMA(1, 0, At, B0); PG8_BAR; PG8_SCHED;
            PG8_STAGE(PG8_SB(0, 1), b2 + hstep, voffB);
            PG8_WAIT_V(6); PG8_BAR; PG8_MMA(1, 1, At, B1); PG8_BAR;
            PG8_LDB(B0, 1, 0); PG8_SCHED; PG8_LDA(At, 1, 0); PG8_STAGE(PG8_SA(0, 1), a2 + hstep, voffA);
            PG8_WAIT_L(8); PG8_BAR; PG8_WAIT_L(0); PG8_MMA(0, 0, At, B0); PG8_BAR; PG8_SCHED;
            PG8_LDB(B1, 1, 1); PG8_STAGE(PG8_SB(1, 0), b3, voffB);
            PG8_BAR; PG8_WAIT_L(0); PG8_MMA(0, 1, At, B1); PG8_BAR;
            PG8_LDA(At, 1, 1); PG8_STAGE(PG8_SA(1, 0), a3, voffA);
            PG8_BAR; PG8_WAIT_L(0); PG8_MMA(1, 0, At, B0); PG8_BAR; PG8_SCHED;
            PG8_STAGE(PG8_SB(1, 1), b3 + hstep, voffB);
            PG8_WAIT_V(6); PG8_BAR; PG8_MMA(1, 1, At, B1); PG8_BAR;
            }
        }
        if constexpr (ALIGN_EPI) { if (wr == 0) PG8_BAR; }
        if constexpr (!Epi::AFTER_DRAIN) { E(acc, cur, wr, wc, fr, fq); S.done(cur); }
        if (!has_next) break;
#pragma unroll
        for (int a = 0; a < 2; ++a)
#pragma unroll
            for (int b = 0; b < 2; ++b)
#pragma unroll
                for (int m = 0; m < 4; ++m)
#pragma unroll
                    for (int n = 0; n < 2; ++n) acc[a][b][m][n] = (f32x4){0.f, 0.f, 0.f, 0.f};
        cur = nxt; cA = nA; cB = nB; ++ui;
        if constexpr (ALIGN_EPI) { if (wr == 1) PG8_BAR; }
    }
    PG8_WAIT_V(0);
    if constexpr (!ALIGN_EPI) { if (wr == 0) PG8_BAR; }
    PG8_BAR;
    if constexpr (Epi::AFTER_DRAIN) { E.fused(acc, cur, wr, wc, fr, fq, lds, wid, lane); S.done(cur); }
#undef PG8_SA
#undef PG8_SB
#undef PG8_STAGE
#undef PG8_LDA
#undef PG8_LDB
#undef PG8_MMA
#undef PG8_WAIT_V
#undef PG8_WAIT_L
#undef PG8_BAR
#undef PG8_SCHED
}
}
using pg8::bf16_t; using pg8::bf16x8; using pg8::f32x4; using pg8::u32x4;
#define LAS __attribute__((address_space(3)))
typedef float f32x16 __attribute__((ext_vector_type(16)));
typedef float f32x2_t __attribute__((ext_vector_type(2)));
typedef __bf16 bf16x2_t __attribute__((ext_vector_type(2)));
typedef unsigned u32x2 __attribute__((ext_vector_type(2)));
typedef short s16x4 __attribute__((ext_vector_type(4)));
#define MFMA32(a, b, c) __builtin_amdgcn_mfma_f32_32x32x16_bf16((a), (b), (c), 0, 0, 0)

constexpr int DM = 1024, SEQ = 16384, NBP = 2, MP = NBP * SEQ, NBS = 16, TS = 32, MS = NBS * TS, MT = MP + MS;
constexpr int NIN = 3328, DFF = 2816, NCH = SEQ / 64;
constexpr float EPS = 1e-6f, LOG2E = 1.4426950408889634f;
constexpr int NTHREADS = 512, NWAVES = 8;
constexpr int LDS_BYTES = 155648;
constexpr int EPT_OFF = 131072, EPT_WAVE = 2560;

constexpr size_t OUT_Y = 0, OUT_PAK = 34078720, OUT_PAV = 34603008, OUT_PGLA = 35127296, OUT_PMK = 35192832, OUT_PMV = 35717120,
                 OUT_SAK = 36241408, OUT_SAV = 36503552, OUT_SGLA = 36765696, OUT_TOTAL = 37289984;
constexpr size_t KiB = 1024, MiB = 1024 * 1024;
constexpr size_t WS_WIN = 1 * MiB, WS_WO = 8 * MiB, WS_WMQ = 10 * MiB, WS_WMKV = 12 * MiB, WS_WMO = 16 * MiB, WS_WGU = 18 * MiB, WS_WD = 29 * MiB;
constexpr size_t WS_MN = 35 * MiB, WS_KMP = 36 * MiB, WS_VMTP = 37 * MiB, WS_KMS = 38 * MiB, WS_VMTS = 46 * MiB;
constexpr size_t WS_H = 54 * MiB, WS_Y = 119 * MiB, WS_U = 184 * MiB, WS_DS = WS_U, WS_DEC = 248 * MiB;
constexpr size_t WS_R = 249 * MiB;
constexpr size_t WS_QA = WS_R, WS_KP = WS_QA + 33280 * KiB, WS_VPT = WS_KP + 32 * MiB, WS_KS = WS_VPT + 32 * MiB, WS_VST = WS_KS + 8704 * KiB,
                 WS_QB = WS_VST + 8704 * KiB, WS_KB = WS_QB + 16640 * KiB, WS_VB = WS_KB + 16640 * KiB, WS_RS = WS_VB + 33280 * KiB, WS_LA = WS_RS + 33280 * KiB,
                 WS_END = WS_LA + 33280 * KiB;
constexpr size_t WS_HID = WS_R;
constexpr size_t WS_VBS = WS_VB + 32 * MiB, WS_LAS = WS_LA + 32 * MiB;
constexpr size_t WS_BT1 = WS_END, WS_BT2 = WS_END + 4 * MiB, WS_WMQN = WS_END + 16 * MiB, WS_VMN = WS_WMQN + 2 * MiB;
static_assert(WS_VMN + 1 * MiB <= 512 * MiB, "ws map 3");
constexpr size_t WS_KBT = WS_END, WS_BC = WS_H, WS_SST = WS_H + 32 * MiB;
static_assert(WS_KBT + 16 * MiB <= 512 * MiB && WS_SST + 32 * MiB <= WS_Y, "ws map 2");
static_assert(WS_HID + (size_t)MT * DFF * 2 <= WS_END && WS_END <= 512 * MiB, "ws map");

struct Params { const float* in[28]; float* out; unsigned char* ws; };
enum { I_XP = 0, I_XS, I_MEM, I_CAK, I_CAV, I_SGLA, I_CMK, I_CMV, I_GPREMIX, I_WIN, I_RELB, I_WA2, I_BA, I_GGLA, I_WO, I_GPOSTMIX, I_GPREMEM, I_GMEM,
       I_WMQ, I_WMK, I_WMV, I_WMO, I_GPOSTMEM, I_GPREFFN, I_WG, I_WU, I_WDN, I_GPOSTFFN };

__device__ __forceinline__ unsigned pk2(float lo, float hi) { f32x2_t v = {lo, hi}; bf16x2_t b = __builtin_convertvector(v, bf16x2_t); return __builtin_bit_cast(unsigned, b); }
__device__ __forceinline__ bf16_t f2bf(float f) { return (bf16_t)(pk2(f, 0.f) & 0xffffu); }
__device__ __forceinline__ float bf2f(unsigned b) { return __uint_as_float(b << 16); }
__device__ __forceinline__ int crow(int i, int h) { return (i & 3) + 8 * (i >> 2) + 4 * h; }
__device__ __forceinline__ float wave_sum(float v) {
#pragma unroll
    for (int o = 1; o < 64; o <<= 1) v += __shfl_xor(v, o);
    return v;
}
__device__ __forceinline__ float silu_f(float x) { return x * __builtin_amdgcn_rcpf(1.f + __expf(-x)); }
__device__ __forceinline__ float logsig(float z) { return fminf(z, 0.f) - __logf(1.f + __expf(-fabsf(z))); }
__device__ __forceinline__ bf16x8 pack8(float x0, float x1, float x2, float x3, float x4, float x5, float x6, float x7) {
    u32x4 w; w.x = pk2(x0, x1); w.y = pk2(x2, x3); w.z = pk2(x4, x5); w.w = pk2(x6, x7); return __builtin_bit_cast(bf16x8, w);
}
#define LDS_WAIT() asm volatile("s_waitcnt lgkmcnt(0)" ::: "memory")

#define EPI_LOOP_BEGIN \
    _Pragma("unroll") for (int ai = 0; ai < 2; ++ai) _Pragma("unroll") for (int m = 0; m < 4; ++m) { \
        const int row = u.pm * 256 + ai * 128 + wr * 64 + m * 16 + fr; \
        _Pragma("unroll") for (int bj = 0; bj < 2; ++bj) _Pragma("unroll") for (int n = 0; n < 2; ++n) { \
            const int c = bj * 128 + wc * 32 + n * 16 + fq * 4; const f32x4 v = acc[ai][bj][m][n];
#define EPI_LOOP_END } asm volatile("" ::: "memory"); }

__device__ __forceinline__ void st_bf4(bf16_t* p, f32x4 v) { u32x2 w; w.x = pk2(v[0], v[1]); w.y = pk2(v[2], v[3]); *(u32x2*)p = w; }
__device__ __forceinline__ void st_bf8(bf16_t* p, f32x4 a, f32x4 b) { u32x4 w; w.x = pk2(a[0], a[1]); w.y = pk2(a[2], a[3]); w.z = pk2(b[0], b[1]); w.w = pk2(b[2], b[3]); *(u32x4*)p = w; }


__device__ __forceinline__ void tr_store_bf16(const f32x4 (&acc)[2][2][4][2], LAS unsigned char* tl, bf16_t* dst  , int wr, int wc, int fr, int fq, int lane) {
#pragma unroll
    for (int ai = 0; ai < 2; ++ai)
#pragma unroll
        for (int bj = 0; bj < 2; ++bj)
#pragma unroll
            for (int mh = 0; mh < 2; ++mh) {
#pragma unroll
                for (int mm = 0; mm < 2; ++mm)
#pragma unroll
                    for (int n = 0; n < 2; ++n) { const f32x4 v = acc[ai][bj][2 * mh + mm][n];
#pragma unroll
                        for (int e = 0; e < 4; ++e) *(LAS bf16_t*)(tl + (8 * fq + 4 * n + e) * 80 + (16 * mm + fr) * 2) = f2bf(v[e]); }
#pragma unroll
                for (int k = 0; k < 2; ++k) { const int p = lane + 64 * k, col = p >> 2, pc = p & 3;
                    const u32x4 w = *(const LAS u32x4*)(tl + col * 80 + pc * 16);
                    *(u32x4*)(dst + (size_t)(128 * bj + 32 * wc + col) * SEQ + 128 * ai + 64 * wr + 32 * mh + 8 * pc) = w; }
            }
}
__device__ __forceinline__ void tr_store_la(const f32x4 (&vals)[2][2][4][2], LAS unsigned char* tl, float* dst, const float* b_alpha, int wr, int wc, int fr, int fq, int lane) {
#pragma unroll
    for (int ai = 0; ai < 2; ++ai)
#pragma unroll
        for (int bj = 0; bj < 2; ++bj)
#pragma unroll
            for (int m = 0; m < 4; ++m) {
#pragma unroll
                for (int n = 0; n < 2; ++n) { const f32x4 v = vals[ai][bj][m][n]; const f32x4 bb = *(const f32x4*)(b_alpha + 128 * bj + 32 * wc + 8 * fq + 4 * n);
#pragma unroll
                    for (int e = 0; e < 4; ++e) *(LAS float*)(tl + (8 * fq + 4 * n + e) * 80 + fr * 4) = logsig(v[e] + bb[e]) * 0.0625f; }
#pragma unroll
                for (int k = 0; k < 2; ++k) { const int p = lane + 64 * k, col = p >> 2, pc = p & 3;
                    const f32x4 w = *(const LAS f32x4*)(tl + col * 80 + pc * 16);
                    *(f32x4*)(dst + (size_t)(128 * bj + 32 * wc + col) * SEQ + 128 * ai + 64 * wr + 16 * m + 4 * pc) = w; }
            }
}

struct EpiIn {
    static constexpr bool PERM = true, AFTER_DRAIN = false;
    unsigned char* wsb; const float* b_alpha; float* outb; LAS unsigned char* ept;
    template <int KIND> __device__ __forceinline__ void run(const f32x4 (&acc)[2][2][4][2], const pg8::Unit& u, int wr, int wc, int fr, int fq) const {
        const int pn = u.pn; const bool isP = u.pm < MP / 256;
        __attribute__((address_space(1))) unsigned char* wg_ = (__attribute__((address_space(1))) unsigned char*)wsb; asm volatile("" : "+s"(wg_)); unsigned char* ws = (unsigned char*)wg_;
        __attribute__((address_space(1))) float* og_ = (__attribute__((address_space(1))) float*)outb; asm volatile("" : "+s"(og_)); float* out = (float*)og_;
        bf16_t* QA = (bf16_t*)(ws + WS_QA); bf16_t* KP = (bf16_t*)(ws + WS_KP); bf16_t* VPT = (bf16_t*)(ws + WS_VPT); bf16_t* KS = (bf16_t*)(ws + WS_KS); bf16_t* VST = (bf16_t*)(ws + WS_VST);
        bf16_t* QB = (bf16_t*)(ws + WS_QB); bf16_t* KB = (bf16_t*)(ws + WS_KB); bf16_t* VB = (bf16_t*)(ws + WS_VB); bf16_t* RS = (bf16_t*)(ws + WS_RS); float* LA = (float*)(ws + WS_LA);
        bf16_t* KBT = (bf16_t*)(ws + WS_KBT); bf16_t* VBS = (bf16_t*)(ws + WS_VBS); float* LAS_ = (float*)(ws + WS_LAS);
        (void)QA; (void)KP; (void)VPT; (void)KS; (void)VST; (void)QB; (void)KB; (void)VB; (void)RS; (void)LA; (void)KBT; (void)VBS; (void)LAS_; (void)out;
#pragma unroll
        for (int ai = 0; ai < 2; ++ai)
#pragma unroll
            for (int m = 0; m < 4; ++m) {
                const int row = u.pm * 256 + ai * 128 + wr * 64 + m * 16 + fr; const int rs = row - MP;
                const int pb = row >> 14, pt = row & (SEQ - 1), sb = rs >> 5, st = rs & 31;
#pragma unroll
                for (int bj = 0; bj < 2; ++bj) {
                    const int c = bj * 128 + wc * 32 + 8 * fq;
                    const f32x4 v0 = acc[ai][bj][m][0], v1 = acc[ai][bj][m][1];
                    if constexpr (KIND == 0) {
                        st_bf8(QA + (size_t)row * 512 + pn * 256 + c, v0 * (0.125f * LOG2E), v1 * (0.125f * LOG2E));
                    } else if constexpr (KIND == 1) {
                        const int col = (pn - 2) * 256 + c;
                        if (isP) { st_bf8(KP + (size_t)row * 512 + col, v0, v1);
                                   if (pt >= SEQ - 512) { float* o = out + OUT_PAK + ((size_t)pb * 512 + (pt - (SEQ - 512))) * 512 + col; *(f32x4*)o = v0; *(f32x4*)(o + 4) = v1; } }
                        else     { st_bf8(KS + ((size_t)sb * 544 + 512 + st) * 512 + col, v0, v1);
                                   float* o = out + OUT_SAK + (size_t)rs * 512 + col; *(f32x4*)o = v0; *(f32x4*)(o + 4) = v1; }
                    } else if constexpr (KIND == 2) {
                        const int col = (pn - 4) * 256 + c;
                        if (isP) { if (pt >= SEQ - 512) { float* o = out + OUT_PAV + ((size_t)pb * 512 + (pt - (SEQ - 512))) * 512 + col; *(f32x4*)o = v0; *(f32x4*)(o + 4) = v1; } }
                        else     { bf16_t* p = VST + ((size_t)sb * 512 + col) * 544 + 512 + st;
                                   p[0] = f2bf(v0[0]); p[544] = f2bf(v0[1]); p[2 * 544] = f2bf(v0[2]); p[3 * 544] = f2bf(v0[3]);
                                   p[4 * 544] = f2bf(v1[0]); p[5 * 544] = f2bf(v1[1]); p[6 * 544] = f2bf(v1[2]); p[7 * 544] = f2bf(v1[3]);
                                   float* o = out + OUT_SAV + (size_t)rs * 512 + col; *(f32x4*)o = v0; *(f32x4*)(o + 4) = v1; }
                    } else if constexpr (KIND == 3) {
                        st_bf8(QB + (size_t)row * 256 + c, v0 * 0.125f, v1 * 0.125f);
                    } else if constexpr (KIND == 4) {
                        st_bf8(KB + (size_t)row * 256 + c, v0, v1);
                    } else if constexpr (KIND == 5) {
                        if (!isP) st_bf8(VBS + (size_t)rs * 512 + (pn - 8) * 256 + c, v0, v1);
                    } else if constexpr (KIND == 6) {
                        f32x4 s0, s1; s0[0] = silu_f(v0[0]); s0[1] = silu_f(v0[1]); s0[2] = silu_f(v0[2]); s0[3] = silu_f(v0[3]);
                        s1[0] = silu_f(v1[0]); s1[1] = silu_f(v1[1]); s1[2] = silu_f(v1[2]); s1[3] = silu_f(v1[3]);
                        st_bf8(RS + (size_t)row * 512 + (pn - 10) * 256 + c, s0, s1);
                    } else {
                        if (!isP) { const f32x4 b0 = *(const f32x4*)(b_alpha + c), b1 = *(const f32x4*)(b_alpha + c + 4); f32x4 s0, s1;
                            s0[0] = logsig(v0[0] + b0[0]) * 0.0625f; s0[1] = logsig(v0[1] + b0[1]) * 0.0625f; s0[2] = logsig(v0[2] + b0[2]) * 0.0625f; s0[3] = logsig(v0[3] + b0[3]) * 0.0625f;
                            s1[0] = logsig(v1[0] + b1[0]) * 0.0625f; s1[1] = logsig(v1[1] + b1[1]) * 0.0625f; s1[2] = logsig(v1[2] + b1[2]) * 0.0625f; s1[3] = logsig(v1[3] + b1[3]) * 0.0625f;
                            float* o = LAS_ + (size_t)rs * 256 + c; *(f32x4*)o = s0; *(f32x4*)(o + 4) = s1; }
                    }
                }
                asm volatile("" ::: "memory");
            }
        if (isP) {
            const int lane = threadIdx.x & 63; const int pb0 = (u.pm * 256) >> 14, pt0 = (u.pm * 256) & (SEQ - 1); LAS unsigned char* tl = ept + (threadIdx.x >> 6) * EPT_WAVE;
            if constexpr (KIND == 2) tr_store_bf16(acc, tl, VPT + ((size_t)pb0 * 512 + (pn - 4) * 256) * SEQ + pt0, wr, wc, fr, fq, lane);
            if constexpr (KIND == 4) tr_store_bf16(acc, tl, KBT + ((size_t)pb0 * 256) * SEQ + pt0, wr, wc, fr, fq, lane);
            if constexpr (KIND == 5) tr_store_bf16(acc, tl, VB + ((size_t)pb0 * 512 + (pn - 8) * 256) * SEQ + pt0, wr, wc, fr, fq, lane);
            if constexpr (KIND == 7) tr_store_la(acc, tl, LA + ((size_t)pb0 * 256) * SEQ + pt0, b_alpha, wr, wc, fr, fq, lane);
        }
    }
    __device__ __forceinline__ void operator()(const f32x4 (&acc)[2][2][4][2], const pg8::Unit& u, int wr, int wc, int fr, int fq) const {
        asm volatile("" : "+v"(fr), "+v"(fq));
        const int pn = u.pn;
        if (pn < 2) run<0>(acc, u, wr, wc, fr, fq);
        else if (pn < 4) run<1>(acc, u, wr, wc, fr, fq);
        else if (pn < 6) run<2>(acc, u, wr, wc, fr, fq);
        else if (pn == 6) run<3>(acc, u, wr, wc, fr, fq);
        else if (pn == 7) run<4>(acc, u, wr, wc, fr, fq);
        else if (pn < 10) run<5>(acc, u, wr, wc, fr, fq);
        else if (pn < 12) run<6>(acc, u, wr, wc, fr, fq);
        else run<7>(acc, u, wr, wc, fr, fq);
    }
};


struct EpiMem {
    static constexpr bool PERM = false, AFTER_DRAIN = false;
    bf16_t *KM, *VMT, *VMN; float* out;
    __device__ __forceinline__ void operator()(const f32x4 (&acc)[2][2][4][2], const pg8::Unit& u, int wr, int wc, int fr, int fq) const {
        asm volatile("" : "+v"(fr), "+v"(fq));
        const int pn = u.pn;
        EPI_LOOP_BEGIN
            if (pn < 4) { const int col = pn * 256 + c;
                *(f32x4*)(out + OUT_PMK + (size_t)row * 1024 + col) = v; st_bf4(KM + (size_t)row * 1024 + col, v);
            } else { const int col = (pn - 4) * 256 + c; const int nb = row >> 8, key = row & 255;
                *(f32x4*)(out + OUT_PMV + (size_t)row * 1024 + col) = v; st_bf4(VMN + (size_t)row * 1024 + col, v);
                bf16_t* p = VMT + ((size_t)nb * 1024 + col) * 256 + key;
                p[0] = f2bf(v[0]); p[256] = f2bf(v[1]); p[512] = f2bf(v[2]); p[768] = f2bf(v[3]);
            }
        EPI_LOOP_END
    }
};

struct EpiPlain {
    static constexpr bool PERM = true, AFTER_DRAIN = false;
    bf16_t* O; int ldc; float scale;
    __device__ __forceinline__ void operator()(const f32x4 (&acc)[2][2][4][2], const pg8::Unit& u, int wr, int wc, int fr, int fq) const {
        asm volatile("" : "+v"(fr), "+v"(fq));
#pragma unroll
        for (int ai = 0; ai < 2; ++ai)
#pragma unroll
            for (int m = 0; m < 4; ++m) { const int row = u.pm * 256 + ai * 128 + wr * 64 + m * 16 + fr;
#pragma unroll
                for (int bj = 0; bj < 2; ++bj) st_bf8(O + (size_t)row * ldc + u.pn * 256 + bj * 128 + wc * 32 + 8 * fq, acc[ai][bj][m][0] * scale, acc[ai][bj][m][1] * scale);
                asm volatile("" ::: "memory"); }
    }
};

struct EpiSwiglu {
    static constexpr bool PERM = true, AFTER_DRAIN = false;
    bf16_t* HID;
    __device__ __forceinline__ void operator()(const f32x4 (&acc)[2][2][4][2], const pg8::Unit& u, int wr, int wc, int fr, int fq) const {
        asm volatile("" : "+v"(fr), "+v"(fq));
#pragma unroll
        for (int ai = 0; ai < 2; ++ai)
#pragma unroll
            for (int m = 0; m < 4; ++m) {
                const int row = u.pm * 256 + ai * 128 + wr * 64 + m * 16 + fr; f32x4 s[2];
#pragma unroll
                for (int n = 0; n < 2; ++n) { const f32x4 g = acc[ai][0][m][n], up = acc[ai][1][m][n];
                    s[n][0] = silu_f(g[0]) * up[0]; s[n][1] = silu_f(g[1]) * up[1]; s[n][2] = silu_f(g[2]) * up[2]; s[n][3] = silu_f(g[3]) * up[3]; }
                st_bf8(HID + (size_t)row * DFF + u.pn * 128 + wc * 32 + 8 * fq, s[0], s[1]);
                asm volatile("" ::: "memory");
            }
    }
};

struct OrderMem {
    pg8::StaticOrder S;
    __device__ bool next(int i, pg8::Unit& u) const { if (!S.next(i, u)) return false; u.pn += (u.pm >= SEQ / 256) ? 4 : 0; return true; }
    __device__ __forceinline__ void a_ready(const pg8::Unit&) const {}
    __device__ __forceinline__ void done(const pg8::Unit&) const {}
};
struct EpiPlainM {
    static constexpr bool PERM = true, AFTER_DRAIN = false;
    bf16_t* O;
    __device__ __forceinline__ void operator()(const f32x4 (&acc)[2][2][4][2], const pg8::Unit& u, int wr, int wc, int fr, int fq) const {
        asm volatile("" : "+v"(fr), "+v"(fq));
#pragma unroll
        for (int ai = 0; ai < 2; ++ai)
#pragma unroll
            for (int m = 0; m < 4; ++m) { const int row = u.pm * 256 + ai * 128 + wr * 64 + m * 16 + fr;
#pragma unroll
                for (int bj = 0; bj < 2; ++bj) st_bf8(O + (size_t)row * 1024 + (u.pn & 3) * 256 + bj * 128 + wc * 32 + 8 * fq, acc[ai][bj][m][0], acc[ai][bj][m][1]);
                asm volatile("" ::: "memory"); }
    }
};
struct EpiSoftmax {
    static constexpr bool PERM = true, AFTER_DRAIN = false;
    bf16_t* O; LAS unsigned char* xl;
    __device__ __forceinline__ void operator()(const f32x4 (&acc_)[2][2][4][2], const pg8::Unit& u, int wr, int wc, int fr, int fq) const {
        asm volatile("" : "+v"(fr), "+v"(fq));
        f32x4 (&acc)[2][2][4][2] = const_cast<f32x4 (&)[2][2][4][2]>(acc_);
        LAS float* MX = (LAS float*)xl; LAS float* SM = (LAS float*)(xl + 4096);
#pragma unroll
        for (int ai = 0; ai < 2; ++ai)
#pragma unroll
            for (int m = 0; m < 4; ++m) { float mx = -INFINITY;
#pragma unroll
                for (int bj = 0; bj < 2; ++bj)
#pragma unroll
                    for (int n = 0; n < 2; ++n) { const f32x4 v = acc[ai][bj][m][n]; mx = fmaxf(fmaxf(mx, fmaxf(v[0], v[1])), fmaxf(v[2], v[3])); }
                mx = fmaxf(mx, __shfl_xor(mx, 16)); mx = fmaxf(mx, __shfl_xor(mx, 32));
                if (fq == 0) MX[(ai * 128 + wr * 64 + m * 16 + fr) * 4 + wc] = mx; }
        asm volatile("s_waitcnt lgkmcnt(0)" ::: "memory"); __builtin_amdgcn_s_barrier(); asm volatile("" ::: "memory");
#pragma unroll
        for (int ai = 0; ai < 2; ++ai)
#pragma unroll
            for (int m = 0; m < 4; ++m) { const f32x4 mv = *(const LAS f32x4*)(MX + (ai * 128 + wr * 64 + m * 16 + fr) * 4);
                const float mx = fmaxf(fmaxf(mv[0], mv[1]), fmaxf(mv[2], mv[3])); float sum = 0.f;
#pragma unroll
                for (int bj = 0; bj < 2; ++bj)
#pragma unroll
                    for (int n = 0; n < 2; ++n) { f32x4 v = acc[ai][bj][m][n];
                        v[0] = __builtin_amdgcn_exp2f(v[0] - mx); v[1] = __builtin_amdgcn_exp2f(v[1] - mx); v[2] = __builtin_amdgcn_exp2f(v[2] - mx); v[3] = __builtin_amdgcn_exp2f(v[3] - mx);
                        acc[ai][bj][m][n] = v; sum += (v[0] + v[1]) + (v[2] + v[3]); }
                sum += __shfl_xor(sum, 16); sum += __shfl_xor(sum, 32);
                if (fq == 0) SM[(ai * 128 + wr * 64 + m * 16 + fr) * 4 + wc] = sum; }
        asm volatile("s_waitcnt lgkmcnt(0)" ::: "memory"); __builtin_amdgcn_s_barrier(); asm volatile("" ::: "memory");
#pragma unroll
        for (int ai = 0; ai < 2; ++ai)
#pragma unroll
            for (int m = 0; m < 4; ++m) { const int rl = ai * 128 + wr * 64 + m * 16 + fr; const f32x4 sv = *(const LAS f32x4*)(SM + rl * 4);
                const float inv = 1.f / ((sv[0] + sv[1]) + (sv[2] + sv[3])); const size_t row = (size_t)u.pm * 256 + rl;
#pragma unroll
                for (int bj = 0; bj < 2; ++bj) st_bf8(O + row * 1024 + (u.pn & 3) * 256 + bj * 128 + wc * 32 + 8 * fq, acc[ai][bj][m][0] * inv, acc[ai][bj][m][1] * inv); }
    }
};
__device__ __forceinline__ void pre_tile(const bf16_t* A, int lda, const bf16_t* Bt, int ldb, bf16_t* O, int ldo, float scale, int lane) {
    const int r = lane & 31, h = lane >> 5; f32x16 a0, a1;
#pragma unroll
    for (int i = 0; i < 16; ++i) { a0[i] = 0.f; a1[i] = 0.f; }
#pragma unroll
    for (int s = 0; s < 16; s += 2) {
        a0 = MFMA32(*(const bf16x8*)(A + (size_t)r * lda + 16 * s + 8 * h), *(const bf16x8*)(Bt + (size_t)r * ldb + 16 * s + 8 * h), a0);
        a1 = MFMA32(*(const bf16x8*)(A + (size_t)r * lda + 16 * (s + 1) + 8 * h), *(const bf16x8*)(Bt + (size_t)r * ldb + 16 * (s + 1) + 8 * h), a1); }
#pragma unroll
    for (int i = 0; i < 16; ++i) O[(size_t)crow(i, h) * ldo + r] = f2bf((a0[i] + a1[i]) * scale);
}
__device__ __forceinline__ void tr_item(const float* src, int lds_, bf16_t* dst, int ldd, int k0, int n0, int drow0, LAS float* scr, int lane) {
#pragma unroll
    for (int i = 0; i < 8; ++i) { const int kk = 8 * i + (lane >> 3), n4 = (lane & 7) * 4;
        const f32x4 w4 = __builtin_nontemporal_load((const f32x4*)(src + (size_t)(k0 + kk) * lds_ + n0 + n4));
        scr[kk * 33 + n4] = w4[0]; scr[kk * 33 + n4 + 1] = w4[1]; scr[kk * 33 + n4 + 2] = w4[2]; scr[kk * 33 + n4 + 3] = w4[3]; }
    LDS_WAIT();
    const int c = lane & 7;
#pragma unroll
    for (int j = 0; j < 4; ++j) { const int n = (lane >> 3) + 8 * j; const LAS float* s = scr + (8 * c) * 33 + n;
        u32x4 o; o.x = pk2(s[0 * 33], s[1 * 33]); o.y = pk2(s[2 * 33], s[3 * 33]); o.z = pk2(s[4 * 33], s[5 * 33]); o.w = pk2(s[6 * 33], s[7 * 33]);
        *(u32x4*)(dst + (size_t)(drow0 + n) * ldd + k0 + 8 * c) = o; }
    LDS_WAIT();
}
template <int NR>
__device__ __forceinline__ void rms_rows_bf16(const float* const (&xrow)[NR], const f32x4 (&gg)[2][2], bf16_t* const (&orow)[NR], int lane) {
    f32x4 v[NR][2][2]; float s[NR];
#pragma unroll
    for (int q = 0; q < NR; ++q)
#pragma unroll
        for (int j = 0; j < 2; ++j)
#pragma unroll
            for (int hf = 0; hf < 2; ++hf) v[q][j][hf] = __builtin_nontemporal_load((const f32x4*)(xrow[q] + 512 * j + 8 * lane + 4 * hf));
#pragma unroll
    for (int q = 0; q < NR; ++q) { s[q] = 0.f;
#pragma unroll
        for (int j = 0; j < 2; ++j)
#pragma unroll
            for (int hf = 0; hf < 2; ++hf) s[q] += (v[q][j][hf][0] * v[q][j][hf][0] + v[q][j][hf][1] * v[q][j][hf][1]) + (v[q][j][hf][2] * v[q][j][hf][2] + v[q][j][hf][3] * v[q][j][hf][3]); }
#pragma unroll
    for (int q = 0; q < NR; ++q) { const float rstd = rsqrtf(wave_sum(s[q]) * (1.f / DM) + EPS);
#pragma unroll
        for (int j = 0; j < 2; ++j) { const f32x4 a = v[q][j][0] * rstd * gg[j][0], b2 = v[q][j][1] * rstd * gg[j][1]; u32x4 w_;
            w_.x = pk2(a[0], a[1]); w_.y = pk2(a[2], a[3]); w_.z = pk2(b2[0], b2[1]); w_.w = pk2(b2[2], b2[3]);
            *(u32x4*)(orow[q] + 512 * j + 8 * lane) = w_; } }
}
struct RowGains { f32x4 gp[2][2], gn[2][2]; bool has_next; };
__device__ __forceinline__ RowGains load_gains(const float* gpost, const float* gnext, int lane) {
    RowGains g; g.has_next = gnext != nullptr;
#pragma unroll
    for (int j = 0; j < 2; ++j)
#pragma unroll
        for (int hf = 0; hf < 2; ++hf) { g.gp[j][hf] = *(const f32x4*)(gpost + 512 * j + 8 * lane + 4 * hf);
            g.gn[j][hf] = gnext ? *(const f32x4*)(gnext + 512 * j + 8 * lane + 4 * hf) : (f32x4){0.f, 0.f, 0.f, 0.f}; }
    return g;
}
__device__ __forceinline__ void unpack8(u32x4 w, f32x4& a, f32x4& b) {
    a[0] = bf2f(w.x & 0xffffu); a[1] = bf2f(w.x >> 16); a[2] = bf2f(w.y & 0xffffu); a[3] = bf2f(w.y >> 16);
    b[0] = bf2f(w.z & 0xffffu); b[1] = bf2f(w.z >> 16); b[2] = bf2f(w.w & 0xffffu); b[3] = bf2f(w.w >> 16); }
__device__ __forceinline__ float sq4(f32x4 v) { return (v[0] * v[0] + v[1] * v[1]) + (v[2] * v[2] + v[3] * v[3]); }
template <int NR, bool XI16, bool XO16>
__device__ __forceinline__ void rowpass_rows(const bf16_t* const (&urow)[NR], const void* const (&xin)[NR], const RowGains& G, void* const (&xout)[NR], bf16_t* const (&hout)[NR], int lane) {
    f32x4 uu[NR][2][2], xx[NR][2][2]; float s[NR], s2[NR];
#pragma unroll
    for (int q = 0; q < NR; ++q)
#pragma unroll
        for (int j = 0; j < 2; ++j) { const int c0 = 512 * j + 8 * lane;
            unpack8(__builtin_nontemporal_load((const u32x4*)(urow[q] + c0)), uu[q][j][0], uu[q][j][1]);
            if constexpr (XI16) unpack8(__builtin_nontemporal_load((const u32x4*)((const bf16_t*)xin[q] + c0)), xx[q][j][0], xx[q][j][1]);
            else { xx[q][j][0] = __builtin_nontemporal_load((const f32x4*)((const float*)xin[q] + c0)); xx[q][j][1] = __builtin_nontemporal_load((const f32x4*)((const float*)xin[q] + c0 + 4)); } }
#pragma unroll
    for (int q = 0; q < NR; ++q) s[q] = (sq4(uu[q][0][0]) + sq4(uu[q][0][1])) + (sq4(uu[q][1][0]) + sq4(uu[q][1][1]));
#pragma unroll
    for (int q = 0; q < NR; ++q) { const float rstd = rsqrtf(wave_sum(s[q]) * (1.f / DM) + EPS); s2[q] = 0.f;
#pragma unroll
        for (int j = 0; j < 2; ++j) { const int c0 = 512 * j + 8 * lane;
#pragma unroll
            for (int hf = 0; hf < 2; ++hf) { uu[q][j][hf] = xx[q][j][hf] + uu[q][j][hf] * rstd * G.gp[j][hf]; s2[q] += sq4(uu[q][j][hf]); }
            if constexpr (XO16) { u32x4 w_; w_.x = pk2(uu[q][j][0][0], uu[q][j][0][1]); w_.y = pk2(uu[q][j][0][2], uu[q][j][0][3]); w_.z = pk2(uu[q][j][1][0], uu[q][j][1][1]); w_.w = pk2(uu[q][j][1][2], uu[q][j][1][3]);
                __builtin_nontemporal_store(w_, (u32x4*)((bf16_t*)xout[q] + c0)); }
            else { __builtin_nontemporal_store(uu[q][j][0], (f32x4*)((float*)xout[q] + c0)); __builtin_nontemporal_store(uu[q][j][1], (f32x4*)((float*)xout[q] + c0 + 4)); } } }
    if (G.has_next) {
#pragma unroll
        for (int q = 0; q < NR; ++q) { const float r2 = rsqrtf(wave_sum(s2[q]) * (1.f / DM) + EPS);
#pragma unroll
            for (int j = 0; j < 2; ++j) { u32x4 w_; const f32x4 a = uu[q][j][0] * r2 * G.gn[j][0], b2 = uu[q][j][1] * r2 * G.gn[j][1];
                w_.x = pk2(a[0], a[1]); w_.y = pk2(a[2], a[3]); w_.z = pk2(b2[0], b2[1]); w_.w = pk2(b2[2], b2[3]);
                *(u32x4*)(hout[q] + 512 * j + 8 * lane) = w_; } }
    }
}
__device__ __forceinline__ const float* xrow_ptr(const float* xp, const float* xs, int m) { return m < MP ? xp + (size_t)m * DM : xs + (size_t)(m - MP) * DM; }

constexpr int BA_KP = 144, BA_VP = 80, BA_VOFF = 32 * BA_KP, BA_WAVE = BA_VOFF + 64 * BA_VP, BA_TAB = 8 * 640 * 4;
__device__ __forceinline__ void band_core(const bf16_t* Qg, const bf16_t* Kp, int ldk, const bf16_t* VTp, int ldvt, int j0, int j1,
                                          const LAS float* rev, int qpos0, bf16_t* Op, LAS unsigned char* wl, int lane) {
    const int r = lane & 31, h = lane >> 5;
    bf16x8 qf[4];
#pragma unroll
    for (int s = 0; s < 4; ++s) qf[s] = *(const bf16x8*)(Qg + (size_t)r * 512 + 16 * s + 8 * h);
    f32x16 o[2];
#pragma unroll
    for (int dt = 0; dt < 2; ++dt)
#pragma unroll
        for (int i = 0; i < 16; ++i) o[dt][i] = 0.f;
    float m_run = -INFINITY, l_run = 0.f;
    const int krl = lane >> 3, kpc = lane & 7, vrl = lane >> 2, vpc = lane & 3;
    u32x4 kst[4], vst[4];
#pragma unroll
    for (int i = 0; i < 4; ++i) { kst[i] = *(const u32x4*)(Kp + (long)(j0 + krl + 8 * i) * ldk + 8 * kpc); vst[i] = *(const u32x4*)(VTp + (long)(vrl + 16 * i) * ldvt + j0 + 8 * vpc); }
    for (int jt = j0; jt < j1; jt += 32) {
#pragma unroll
        for (int i = 0; i < 4; ++i) { *(LAS u32x4*)(wl + (krl + 8 * i) * BA_KP + 16 * kpc) = kst[i]; *(LAS u32x4*)(wl + BA_VOFF + (vrl + 16 * i) * BA_VP + 16 * vpc) = vst[i]; }
        { const int jn = (jt + 32 < j1) ? jt + 32 : jt;
#pragma unroll
          for (int i = 0; i < 4; ++i) { kst[i] = *(const u32x4*)(Kp + (long)(jn + krl + 8 * i) * ldk + 8 * kpc); vst[i] = *(const u32x4*)(VTp + (long)(vrl + 16 * i) * ldvt + jn + 8 * vpc); } }
        f32x16 sacc;
#pragma unroll
        for (int i = 0; i < 16; ++i) sacc[i] = 0.f;
#pragma unroll
        for (int s = 0; s < 4; ++s) sacc = MFMA32(*(const LAS bf16x8*)(wl + r * BA_KP + (16 * s + 8 * h) * 2), qf[s], sacc);
        const LAS float* rb = rev + (576 - qpos0 - r + jt + 4 * h);
        float mx = -INFINITY;
#pragma unroll
        for (int i = 0; i < 16; ++i) { const float t = sacc[i] + rb[(i & 3) + 8 * (i >> 2)]; sacc[i] = t; mx = fmaxf(mx, t); }
        mx = fmaxf(mx, __shfl_xor(mx, 32));
        const float m_new = fmaxf(m_run, mx); const float alpha = __builtin_amdgcn_exp2f(m_run - m_new); m_run = m_new;
        float ps = 0.f;
#pragma unroll
        for (int i = 0; i < 16; ++i) { const float p = __builtin_amdgcn_exp2f(sacc[i] - m_new); sacc[i] = p; ps += p; }
        l_run = l_run * alpha + ps;
        if (__any(alpha != 1.f)) {
#pragma unroll
            for (int dt = 0; dt < 2; ++dt)
#pragma unroll
                for (int i = 0; i < 16; ++i) o[dt][i] *= alpha;
        }
        bf16x8 pf[2];
        pf[0] = pack8(sacc[0], sacc[1], sacc[2], sacc[3], sacc[4], sacc[5], sacc[6], sacc[7]);
        pf[1] = pack8(sacc[8], sacc[9], sacc[10], sacc[11], sacc[12], sacc[13], sacc[14], sacc[15]);
#pragma unroll
        for (int dt = 0; dt < 2; ++dt)
#pragma unroll
            for (int s2 = 0; s2 < 2; ++s2) {
                const LAS unsigned char* vp = wl + BA_VOFF + (32 * dt + r) * BA_VP + (16 * s2 + 4 * h) * 2;
                const s16x4 lo = *(const LAS s16x4*)vp, hi = *(const LAS s16x4*)(vp + 16);
                bf16x8 vf; vf[0] = lo[0]; vf[1] = lo[1]; vf[2] = lo[2]; vf[3] = lo[3]; vf[4] = hi[0]; vf[5] = hi[1]; vf[6] = hi[2]; vf[7] = hi[3];
                o[dt] = MFMA32(vf, pf[s2], o[dt]);
            }
    }
    const float l = l_run + __shfl_xor(l_run, 32); const float inv = 1.f / l;
#pragma unroll
    for (int dt = 0; dt < 2; ++dt)
#pragma unroll
        for (int g = 0; g < 4; ++g) {
            f32x4 v; v[0] = o[dt][4 * g] * inv; v[1] = o[dt][4 * g + 1] * inv; v[2] = o[dt][4 * g + 2] * inv; v[3] = o[dt][4 * g + 3] * inv;
            st_bf4(Op + (size_t)r * 1024 + 32 * dt + 8 * g + 4 * h, v);
        }
}

__device__ __forceinline__ void band_core64(const bf16_t* Qg, const bf16_t* Kp, int ldk, const bf16_t* VTp, int ldvt, int j0, int j1,
                                            const LAS float* rev, bf16_t* Op, LAS unsigned char* wl, int lane) {
    const int r = lane & 31, h = lane >> 5;
    bf16x8 qf[2][4];
    {
        const int qr_ = lane >> 3, qp_ = lane & 7; u32x4 qs[8];
#pragma unroll
        for (int i = 0; i < 8; ++i) qs[i] = *(const u32x4*)(Qg + (size_t)(qr_ + 8 * i) * 512 + 8 * qp_);
#pragma unroll
        for (int i = 0; i < 8; ++i) *(LAS u32x4*)(wl + (qr_ + 8 * i) * 144 + 16 * qp_) = qs[i];
#pragma unroll
        for (int qt = 0; qt < 2; ++qt)
#pragma unroll
            for (int s = 0; s < 4; ++s) qf[qt][s] = *(const LAS bf16x8*)(wl + (32 * qt + r) * 144 + (16 * s + 8 * h) * 2);
    }
    f32x16 o[2][2];
#pragma unroll
    for (int qt = 0; qt < 2; ++qt)
#pragma unroll
        for (int dt = 0; dt < 2; ++dt)
#pragma unroll
            for (int i = 0; i < 16; ++i) o[qt][dt][i] = 0.f;
    float m_run[2] = {-INFINITY, -INFINITY}, l_run[2] = {0.f, 0.f};
    const float bfar = rev[0];
    const int krl = lane >> 3, kpc = lane & 7, vrl = lane >> 2, vpc = lane & 3;
    u32x4 kst[4], vst[4];
#pragma unroll
    for (int i = 0; i < 4; ++i) { kst[i] = *(const u32x4*)(Kp + (long)(j0 + krl + 8 * i) * ldk + 8 * kpc); vst[i] = *(const u32x4*)(VTp + (long)(vrl + 16 * i) * ldvt + j0 + 8 * vpc); }
    for (int jt = j0; jt < j1; jt += 32) {
#pragma unroll
        for (int i = 0; i < 4; ++i) { *(LAS u32x4*)(wl + (krl + 8 * i) * BA_KP + 16 * kpc) = kst[i]; *(LAS u32x4*)(wl + BA_VOFF + (vrl + 16 * i) * BA_VP + 16 * vpc) = vst[i]; }
        { const int jn = (jt + 32 < j1) ? jt + 32 : jt;
#pragma unroll
          for (int i = 0; i < 4; ++i) { kst[i] = *(const u32x4*)(Kp + (long)(jn + krl + 8 * i) * ldk + 8 * kpc); vst[i] = *(const u32x4*)(VTp + (long)(vrl + 16 * i) * ldvt + jn + 8 * vpc); } }
        f32x16 sa[2];
#pragma unroll
        for (int i = 0; i < 16; ++i) { sa[0][i] = 0.f; sa[1][i] = 0.f; }
#pragma unroll
        for (int s = 0; s < 4; ++s) { const bf16x8 kf = *(const LAS bf16x8*)(wl + r * BA_KP + (16 * s + 8 * h) * 2);
            sa[0] = MFMA32(kf, qf[0][s], sa[0]); sa[1] = MFMA32(kf, qf[1][s], sa[1]); }
        bf16x8 pf[2][2];
#pragma unroll
        for (int qt = 0; qt < 2; ++qt) {
            float mx = -INFINITY;
            if (jt <= 224 + 32 * qt) {
#pragma unroll
                for (int i = 0; i < 16; ++i) { const float t = sa[qt][i] + bfar; sa[qt][i] = t; mx = fmaxf(mx, t); }
            } else {
                const LAS float* rb = rev + (64 - 32 * qt - r + jt + 4 * h);
#pragma unroll
                for (int i = 0; i < 16; ++i) { const float t = sa[qt][i] + rb[(i & 3) + 8 * (i >> 2)]; sa[qt][i] = t; mx = fmaxf(mx, t); }
            }
            mx = fmaxf(mx, __shfl_xor(mx, 32));
            const float m_new = fmaxf(m_run[qt], mx); const float alpha = __builtin_amdgcn_exp2f(m_run[qt] - m_new); m_run[qt] = m_new;
            float ps = 0.f;
#pragma unroll
            for (int i = 0; i < 16; ++i) { const float p = __builtin_amdgcn_exp2f(sa[qt][i] - m_new); sa[qt][i] = p; ps += p; }
            l_run[qt] = l_run[qt] * alpha + ps;
            if (__any(alpha != 1.f)) {
#pragma unroll
                for (int dt = 0; dt < 2; ++dt)
#pragma unroll
                    for (int i = 0; i < 16; ++i) o[qt][dt][i] *= alpha;
            }
            pf[qt][0] = pack8(sa[qt][0], sa[qt][1], sa[qt][2], sa[qt][3], sa[qt][4], sa[qt][5], sa[qt][6], sa[qt][7]);
            pf[qt][1] = pack8(sa[qt][8], sa[qt][9], sa[qt][10], sa[qt][11], sa[qt][12], sa[qt][13], sa[qt][14], sa[qt][15]);
        }
#pragma unroll
        for (int dt = 0; dt < 2; ++dt)
#pragma unroll
            for (int s2 = 0; s2 < 2; ++s2) {
                const LAS unsigned char* vp = wl + BA_VOFF + (32 * dt + r) * BA_VP + (16 * s2 + 4 * h) * 2;
                const s16x4 lo = *(const LAS s16x4*)vp, hi = *(const LAS s16x4*)(vp + 16);
                bf16x8 vf; vf[0] = lo[0]; vf[1] = lo[1]; vf[2] = lo[2]; vf[3] = lo[3]; vf[4] = hi[0]; vf[5] = hi[1]; vf[6] = hi[2]; vf[7] = hi[3];
                o[0][dt] = MFMA32(vf, pf[0][s2], o[0][dt]); o[1][dt] = MFMA32(vf, pf[1][s2], o[1][dt]);
            }
    }
#pragma unroll
    for (int qt = 0; qt < 2; ++qt) {
        const float l = l_run[qt] + __shfl_xor(l_run[qt], 32); const float inv = 1.f / l;
#pragma unroll
        for (int dt = 0; dt < 2; ++dt)
#pragma unroll
            for (int g = 0; g < 4; ++g) { u32x2 w2; w2.x = pk2(o[qt][dt][4 * g] * inv, o[qt][dt][4 * g + 1] * inv); w2.y = pk2(o[qt][dt][4 * g + 2] * inv, o[qt][dt][4 * g + 3] * inv);
                *(LAS u32x2*)(wl + (32 * qt + r) * 144 + (32 * dt + 8 * g + 4 * h) * 2) = w2; }
    }
#pragma unroll
    for (int k = 0; k < 8; ++k) { const int p = lane + 64 * k, row = p >> 3, pc = p & 7;
        *(u32x4*)(Op + (size_t)row * 1024 + 8 * pc) = *(const LAS u32x4*)(wl + row * 144 + 16 * pc); }
}

constexpr int GA_WAVE = 64 * 144;
__device__ __forceinline__ void gla_wave_a(LAS unsigned char* wl, const float* LAT, const bf16_t* KBT, const bf16_t* VBT, float* BC, float* DST, float* DEC, int unit, int lane) {
    const int c = unit & (NCH - 1), bh = unit >> 8, hb = bh & 3, b = bh >> 2;
    const size_t row0 = (size_t)b * SEQ + (size_t)c * 64;
    const int r = lane & 31, h = lane >> 5;
    float bc[64];
    { const float* lp = LAT + ((size_t)bh * 64 + lane) * SEQ + c * 64;
#pragma unroll
      for (int i = 0; i < 16; ++i) { const f32x4 v = *(const f32x4*)(lp + 4 * i); bc[4 * i] = v[0]; bc[4 * i + 1] = v[1]; bc[4 * i + 2] = v[2]; bc[4 * i + 3] = v[3]; } }
    u32x4 kk[8];
    { const bf16_t* kp = KBT + ((size_t)bh * 64 + lane) * SEQ + c * 64;
#pragma unroll
      for (int i = 0; i < 8; ++i) kk[i] = *(const u32x4*)(kp + 8 * i); }
#pragma unroll
    for (int t = 1; t < 64; ++t) bc[t] += bc[t - 1];
    { float* bp = BC + row0 * 256 + hb * 64 + lane;
#pragma unroll
      for (int t = 0; t < 64; ++t) bp[(size_t)t * 256] = bc[t]; }
    const float bl = bc[63];
    DEC[(size_t)unit * 64 + lane] = __expf(bl);
#pragma unroll
    for (int i = 0; i < 8; ++i) { u32x4 w;
#pragma unroll
        for (int e = 0; e < 4; ++e) { const unsigned kw = kk[i][e]; const int t = 8 * i + 2 * e;
            w[e] = pk2(bf2f(kw & 0xffffu) * __expf(bl - bc[t]), bf2f(kw >> 16) * __expf(bl - bc[t + 1])); }
        *(LAS u32x4*)(wl + lane * 144 + 16 * i) = w; }
    const bf16_t* vbase = VBT + ((size_t)bh * 128) * SEQ + c * 64;
    float* dst = DST + (size_t)unit * 8192;
#pragma unroll 1
    for (int dvt = 0; dvt < 4; ++dvt) {
        f32x16 a0, a1;
#pragma unroll
        for (int i = 0; i < 16; ++i) { a0[i] = 0.f; a1[i] = 0.f; }
#pragma unroll
        for (int s = 0; s < 4; ++s) {
            const bf16x8 va = *(const bf16x8*)(vbase + (size_t)(32 * dvt + r) * SEQ + 16 * s + 8 * h);
            a0 = MFMA32(va, *(const LAS bf16x8*)(wl + r * 144 + (16 * s + 8 * h) * 2), a0);
            a1 = MFMA32(va, *(const LAS bf16x8*)(wl + (32 + r) * 144 + (16 * s + 8 * h) * 2), a1);
        }
#pragma unroll
        for (int i = 0; i < 16; ++i) { float* p = dst + (32 * dvt + crow(i, h)) * 64 + r; p[0] = a0[i]; p[32] = a1[i]; }
    }
}

constexpr int GB_P = 272, GB_WAVE = 18176;
__device__ __forceinline__ void gla_wave_b(LAS unsigned char* wl, const float* BC, const bf16_t* QB, const bf16_t* KB, const bf16_t* VBT, const bf16_t* SST, const bf16_t* RS, const float* ggla, bf16_t* Y, int unit, int lane) {
    const int c = unit & (NCH - 1), bh = unit >> 8, hb = bh & 3, b = bh >> 2;
    const size_t row0 = (size_t)b * SEQ + (size_t)c * 64;
    const int r = lane & 31, h = lane >> 5;
    bf16x8 qt[2][4], kt[2][4];
    {
        const int br_ = lane >> 4, bp_ = lane & 15, qr_ = lane >> 3, qp_ = lane & 7;
        f32x4 bst[2][8]; u32x4 qst[2][4], kst[2][4];
#pragma unroll
        for (int rt = 0; rt < 2; ++rt) {
#pragma unroll
            for (int i = 0; i < 8; ++i) bst[rt][i] = *(const f32x4*)(BC + (row0 + 32 * rt + br_ + 4 * i) * 256 + hb * 64 + 4 * bp_);
#pragma unroll
            for (int i = 0; i < 4; ++i) { qst[rt][i] = *(const u32x4*)(QB + (row0 + 32 * rt + qr_ + 8 * i) * 256 + hb * 64 + 8 * qp_); kst[rt][i] = *(const u32x4*)(KB + (row0 + 32 * rt + qr_ + 8 * i) * 256 + hb * 64 + 8 * qp_); }
        }
#pragma unroll
        for (int rt = 0; rt < 2; ++rt) {
#pragma unroll
            for (int i = 0; i < 8; ++i) *(LAS f32x4*)(wl + (br_ + 4 * i) * 272 + 16 * bp_) = bst[rt][i];
#pragma unroll
            for (int i = 0; i < 4; ++i) { *(LAS u32x4*)(wl + 8704 + (qr_ + 8 * i) * 144 + 16 * qp_) = qst[rt][i]; *(LAS u32x4*)(wl + 13312 + (qr_ + 8 * i) * 144 + 16 * qp_) = kst[rt][i]; }
#pragma unroll
            for (int s = 0; s < 4; ++s) {
                const f32x4 b0 = *(const LAS f32x4*)(wl + r * 272 + (16 * s + 8 * h) * 4), b1 = *(const LAS f32x4*)(wl + r * 272 + (16 * s + 8 * h) * 4 + 16);
                const u32x4 qw = *(const LAS u32x4*)(wl + 8704 + r * 144 + (16 * s + 8 * h) * 2), kw = *(const LAS u32x4*)(wl + 13312 + r * 144 + (16 * s + 8 * h) * 2);
                float e[8], qv[8], kv[8];
#pragma unroll
                for (int j = 0; j < 4; ++j) { e[j] = __expf(b0[j]); e[4 + j] = __expf(b1[j]); }
#pragma unroll
                for (int j = 0; j < 4; ++j) { qv[2 * j] = bf2f(qw[j] & 0xffffu) * e[2 * j]; qv[2 * j + 1] = bf2f(qw[j] >> 16) * e[2 * j + 1];
                    kv[2 * j] = bf2f(kw[j] & 0xffffu) * __builtin_amdgcn_rcpf(e[2 * j]); kv[2 * j + 1] = bf2f(kw[j] >> 16) * __builtin_amdgcn_rcpf(e[2 * j + 1]); }
                qt[rt][s] = pack8(qv[0], qv[1], qv[2], qv[3], qv[4], qv[5], qv[6], qv[7]);
                kt[rt][s] = pack8(kv[0], kv[1], kv[2], kv[3], kv[4], kv[5], kv[6], kv[7]);
            }
        }
    }
    f32x16 t00, t01, t11;
#pragma unroll
    for (int i = 0; i < 16; ++i) { t00[i] = 0.f; t01[i] = 0.f; t11[i] = 0.f; }
#pragma unroll
    for (int s = 0; s < 4; ++s) { t00 = MFMA32(kt[0][s], qt[0][s], t00); t01 = MFMA32(kt[0][s], qt[1][s], t01); t11 = MFMA32(kt[1][s], qt[1][s], t11); }
#pragma unroll
    for (int i = 0; i < 16; ++i) { const bool keep = crow(i, h) <= r; t00[i] = keep ? t00[i] : 0.f; t11[i] = keep ? t11[i] : 0.f; }
    bf16x8 p00[2], p01[2], p11[2];
#pragma unroll
    for (int s2 = 0; s2 < 2; ++s2) {
        p00[s2] = pack8(t00[8 * s2], t00[8 * s2 + 1], t00[8 * s2 + 2], t00[8 * s2 + 3], t00[8 * s2 + 4], t00[8 * s2 + 5], t00[8 * s2 + 6], t00[8 * s2 + 7]);
        p01[s2] = pack8(t01[8 * s2], t01[8 * s2 + 1], t01[8 * s2 + 2], t01[8 * s2 + 3], t01[8 * s2 + 4], t01[8 * s2 + 5], t01[8 * s2 + 6], t01[8 * s2 + 7]);
        p11[s2] = pack8(t11[8 * s2], t11[8 * s2 + 1], t11[8 * s2 + 2], t11[8 * s2 + 3], t11[8 * s2 + 4], t11[8 * s2 + 5], t11[8 * s2 + 6], t11[8 * s2 + 7]);
    }
    const bf16_t* vbase = VBT + ((size_t)bh * 128) * SEQ + c * 64;
    const bf16_t* sbase = SST + (size_t)unit * 8192;
    float ss0 = 0.f, ss1 = 0.f;
#pragma unroll 1
    for (int dvt = 0; dvt < 4; ++dvt) {
        f32x16 o0, o1;
#pragma unroll
        for (int i = 0; i < 16; ++i) { o0[i] = 0.f; o1[i] = 0.f; }
#pragma unroll
        for (int s = 0; s < 4; ++s) { const bf16x8 sa = *(const bf16x8*)(sbase + (32 * dvt + r) * 64 + 16 * s + 8 * h); o0 = MFMA32(sa, qt[0][s], o0); o1 = MFMA32(sa, qt[1][s], o1); }
#pragma unroll
        for (int jt = 0; jt < 2; ++jt)
#pragma unroll
            for (int s2 = 0; s2 < 2; ++s2) {
                const bf16_t* vp = vbase + (size_t)(32 * dvt + r) * SEQ + 32 * jt + 16 * s2 + 4 * h;
                const s16x4 lo = *(const s16x4*)vp, hi = *(const s16x4*)(vp + 8);
                bf16x8 vf; vf[0] = lo[0]; vf[1] = lo[1]; vf[2] = lo[2]; vf[3] = lo[3]; vf[4] = hi[0]; vf[5] = hi[1]; vf[6] = hi[2]; vf[7] = hi[3];
                if (jt == 0) { o0 = MFMA32(vf, p00[s2], o0); o1 = MFMA32(vf, p01[s2], o1); } else o1 = MFMA32(vf, p11[s2], o1);
            }
#pragma unroll
        for (int i = 0; i < 16; ++i) { ss0 += o0[i] * o0[i]; ss1 += o1[i] * o1[i]; }
#pragma unroll
        for (int g = 0; g < 4; ++g) { u32x2 w0, w1; w0.x = pk2(o0[4 * g], o0[4 * g + 1]); w0.y = pk2(o0[4 * g + 2], o0[4 * g + 3]); w1.x = pk2(o1[4 * g], o1[4 * g + 1]); w1.y = pk2(o1[4 * g + 2], o1[4 * g + 3]);
            *(LAS u32x2*)(wl + r * GB_P + (32 * dvt + 8 * g + 4 * h) * 2) = w0; *(LAS u32x2*)(wl + (32 + r) * GB_P + (32 * dvt + 8 * g + 4 * h) * 2) = w1; }
    }
    ss0 += __shfl_xor(ss0, 32); ss1 += __shfl_xor(ss1, 32);
    LAS float* rsv = (LAS float*)(wl + 64 * GB_P);
    if (h == 0) { rsv[r] = rsqrtf(ss0 * (1.f / 128.f) + EPS); rsv[32 + r] = rsqrtf(ss1 * (1.f / 128.f) + EPS); }
#pragma unroll 4
    for (int k = 0; k < 16; ++k) { const int p = lane + 64 * k, tok = p >> 4, pc = p & 15;
        const u32x4 ow = *(const LAS u32x4*)(wl + tok * GB_P + pc * 16); const float rs = rsv[tok];
        const f32x4 g0 = *(const f32x4*)(ggla + hb * 128 + 8 * pc), g1 = *(const f32x4*)(ggla + hb * 128 + 8 * pc + 4);
        const u32x4 gw = *(const u32x4*)(RS + (row0 + tok) * 512 + hb * 128 + 8 * pc);
        u32x4 yo;
        yo.x = pk2(bf2f(ow.x & 0xffffu) * rs * g0[0] * bf2f(gw.x & 0xffffu), bf2f(ow.x >> 16) * rs * g0[1] * bf2f(gw.x >> 16));
        yo.y = pk2(bf2f(ow.y & 0xffffu) * rs * g0[2] * bf2f(gw.y & 0xffffu), bf2f(ow.y >> 16) * rs * g0[3] * bf2f(gw.y >> 16));
        yo.z = pk2(bf2f(ow.z & 0xffffu) * rs * g1[0] * bf2f(gw.z & 0xffffu), bf2f(ow.z >> 16) * rs * g1[1] * bf2f(gw.z >> 16));
        yo.w = pk2(bf2f(ow.w & 0xffffu) * rs * g1[2] * bf2f(gw.w & 0xffffu), bf2f(ow.w >> 16) * rs * g1[3] * bf2f(gw.w >> 16));
        *(u32x4*)(Y + (row0 + tok) * 1024 + 512 + hb * 128 + 8 * pc) = yo; }
}

__device__ __forceinline__ void gla_sample_unit(LAS unsigned char* lds, const float* LA, const bf16_t* QB, const bf16_t* KB, const bf16_t* VB, const bf16_t* RS,
                                                const float* S0, const float* ggla, bf16_t* Y, float* Sout, int b, int hb, int tid) {
    LAS float* q = (LAS float*)lds; LAS float* k = q + 2048; LAS float* a = k + 2048; LAS float* v = a + 2048; LAS float* part = v + 4096; LAS float* O = part + 512;
    const size_t row0 = (size_t)MP + (size_t)b * TS;
#pragma unroll
    for (int i = 0; i < 4; ++i) { const int idx = tid + 512 * i, t = idx >> 6, dk = idx & 63;
        q[idx] = bf2f(QB[(row0 + t) * 256 + hb * 64 + dk]); k[idx] = bf2f(KB[(row0 + t) * 256 + hb * 64 + dk]); a[idx] = __expf(LA[((size_t)b * TS + t) * 256 + hb * 64 + dk]); }
#pragma unroll
    for (int i = 0; i < 8; ++i) { const int idx = tid + 512 * i, t = idx >> 7, dv = idx & 127; v[idx] = bf2f(VB[((size_t)b * TS + t) * 512 + hb * 128 + dv]); }
    const int dv = tid & 127, g = tid >> 7;
    float S[16];
    const float* s0 = S0 + (size_t)(b * 4 + hb) * 8192;
#pragma unroll
    for (int i = 0; i < 16; ++i) S[i] = s0[(16 * g + i) * 128 + dv];
    __syncthreads();
    for (int t = 0; t < TS; ++t) {
        const float vv = v[t * 128 + dv]; float p = 0.f;
#pragma unroll
        for (int i = 0; i < 16; ++i) { const int dk = 16 * g + i; S[i] = a[t * 64 + dk] * S[i] + k[t * 64 + dk] * vv; p += q[t * 64 + dk] * S[i]; }
        part[g * 128 + dv] = p;
        __syncthreads();
        if (tid < 128) O[t * 128 + tid] = (part[tid] + part[128 + tid]) + (part[256 + tid] + part[384 + tid]);
        __syncthreads();
    }
    float* so = Sout + (size_t)(b * 4 + hb) * 8192;
#pragma unroll
    for (int i = 0; i < 16; ++i) so[(16 * g + i) * 128 + dv] = S[i];
    { const int lane = tid & 63, wave = tid >> 6;
#pragma unroll
      for (int tt = 0; tt < 4; ++tt) { const int t = 4 * wave + tt; const float o0 = O[t * 128 + lane], o1 = O[t * 128 + 64 + lane];
          const float rs = rsqrtf(wave_sum(o0 * o0 + o1 * o1) * (1.f / 128.f) + EPS);
          Y[(row0 + t) * 1024 + 512 + hb * 128 + lane] = f2bf(o0 * rs * ggla[hb * 128 + lane] * bf2f(RS[(row0 + t) * 512 + hb * 128 + lane]));
          Y[(row0 + t) * 1024 + 512 + hb * 128 + 64 + lane] = f2bf(o1 * rs * ggla[hb * 128 + 64 + lane] * bf2f(RS[(row0 + t) * 512 + hb * 128 + 64 + lane])); } }
    __syncthreads();
}


constexpr int MA_QP = 528, MA_QS1 = 16896, MA_PS = 33792, MA_MX = 50688, MA_SUM = 51712, MA_OS = 52736;
__device__ __forceinline__ void mem_attn_item(LAS unsigned char* lds, const bf16_t* Kh, const bf16_t* VTh, const bf16_t* Qh, bf16_t* Oh, int ntiles, int tid) {
    const int lane = tid & 63, wave = tid >> 6, r = lane & 31, h = lane >> 5;
    LAS unsigned char* Ps = lds + MA_PS; LAS float* MX = (LAS float*)(lds + MA_MX); LAS float* SUM = (LAS float*)(lds + MA_SUM);
    bf16x8 kf[16], vf[16];
#pragma unroll
    for (int s = 0; s < 16; ++s) kf[s] = *(const bf16x8*)(Kh + (size_t)(32 * wave + r) * 1024 + 16 * s + 8 * h);
#pragma unroll
    for (int s = 0; s < 16; ++s) vf[s] = *(const bf16x8*)(VTh + (size_t)(32 * wave + r) * 256 + 16 * s + 8 * h);
    const int q0 = tid >> 5, c0 = tid & 31;
    u32x4 qreg[2];
    qreg[0] = *(const u32x4*)(Qh + (size_t)q0 * 1024 + 8 * c0); qreg[1] = *(const u32x4*)(Qh + (size_t)(q0 + 16) * 1024 + 8 * c0);
    *(LAS u32x4*)(lds + q0 * MA_QP + 16 * c0) = qreg[0]; *(LAS u32x4*)(lds + (q0 + 16) * MA_QP + 16 * c0) = qreg[1];
    for (int t = 0; t < ntiles; ++t) {
        const LAS unsigned char* cur = lds + ((t & 1) ? MA_QS1 : 0); LAS unsigned char* nxt = lds + ((t & 1) ? 0 : MA_QS1);
        const bool more = t + 1 < ntiles;
        if (more) { const bf16_t* qn = Qh + (size_t)(32 * (t + 1)) * 1024;
            qreg[0] = *(const u32x4*)(qn + (size_t)q0 * 1024 + 8 * c0); qreg[1] = *(const u32x4*)(qn + (size_t)(q0 + 16) * 1024 + 8 * c0); }
        if (t == 0) __syncthreads();
        f32x16 sacc, sacb;
#pragma unroll
        for (int i = 0; i < 16; ++i) { sacc[i] = 0.f; sacb[i] = 0.f; }
#pragma unroll
        for (int s = 0; s < 16; s += 2) {
            sacc = MFMA32(kf[s], *(const LAS bf16x8*)(cur + r * MA_QP + (16 * s + 8 * h) * 2), sacc);
            sacb = MFMA32(kf[s + 1], *(const LAS bf16x8*)(cur + r * MA_QP + (16 * (s + 1) + 8 * h) * 2), sacb); }
#pragma unroll
        for (int i = 0; i < 16; ++i) sacc[i] += sacb[i];
        float mx = sacc[0];
#pragma unroll
        for (int i = 1; i < 16; ++i) mx = fmaxf(mx, sacc[i]);
        mx = fmaxf(mx, __shfl_xor(mx, 32));
        if (h == 0) MX[wave * 32 + r] = mx;
        __syncthreads();
        float m = MX[r];
#pragma unroll
        for (int w = 1; w < 8; ++w) m = fmaxf(m, MX[w * 32 + r]);
        float ps = 0.f;
#pragma unroll
        for (int i = 0; i < 16; ++i) { const float p = __builtin_amdgcn_exp2f(sacc[i] - m); sacc[i] = p; ps += p; }
        ps += __shfl_xor(ps, 32);
        if (h == 0) SUM[wave * 32 + r] = ps;
#pragma unroll
        for (int g = 0; g < 4; ++g) { u32x2 w2; w2.x = pk2(sacc[4 * g], sacc[4 * g + 1]); w2.y = pk2(sacc[4 * g + 2], sacc[4 * g + 3]);
            *(LAS u32x2*)(Ps + r * MA_QP + (32 * wave + 8 * g + 4 * h) * 2) = w2; }
        if (more) { *(LAS u32x4*)(nxt + q0 * MA_QP + 16 * c0) = qreg[0]; *(LAS u32x4*)(nxt + (q0 + 16) * MA_QP + 16 * c0) = qreg[1]; }
        if (t > 0) {
            bf16_t* op = Oh + (size_t)(32 * (t - 1)) * 1024;
            *(u32x4*)(op + (size_t)q0 * 1024 + 8 * c0) = *(const LAS u32x4*)(lds + MA_OS + q0 * MA_QP + 16 * c0);
            *(u32x4*)(op + (size_t)(q0 + 16) * 1024 + 8 * c0) = *(const LAS u32x4*)(lds + MA_OS + (q0 + 16) * MA_QP + 16 * c0); }
        __syncthreads();
        f32x16 o, ob;
#pragma unroll
        for (int i = 0; i < 16; ++i) { o[i] = 0.f; ob[i] = 0.f; }
#pragma unroll
        for (int s = 0; s < 16; s += 2) {
            o = MFMA32(vf[s], *(const LAS bf16x8*)(Ps + r * MA_QP + (16 * s + 8 * h) * 2), o);
            ob = MFMA32(vf[s + 1], *(const LAS bf16x8*)(Ps + r * MA_QP + (16 * (s + 1) + 8 * h) * 2), ob); }
#pragma unroll
        for (int i = 0; i < 16; ++i) o[i] += ob[i];
        float l = SUM[r];
#pragma unroll
        for (int w = 1; w < 8; ++w) l += SUM[w * 32 + r];
        const float inv = 1.f / l;
#pragma unroll
        for (int g = 0; g < 4; ++g) { u32x2 w2; w2.x = pk2(o[4 * g] * inv, o[4 * g + 1] * inv); w2.y = pk2(o[4 * g + 2] * inv, o[4 * g + 3] * inv);
            *(LAS u32x2*)(lds + MA_OS + r * MA_QP + (32 * wave + 8 * g + 4 * h) * 2) = w2; }
    }
    __syncthreads();
    { bf16_t* op = Oh + (size_t)(32 * (ntiles - 1)) * 1024;
      *(u32x4*)(op + (size_t)q0 * 1024 + 8 * c0) = *(const LAS u32x4*)(lds + MA_OS + q0 * MA_QP + 16 * c0);
      *(u32x4*)(op + (size_t)(q0 + 16) * 1024 + 8 * c0) = *(const LAS u32x4*)(lds + MA_OS + (q0 + 16) * MA_QP + 16 * c0); }
    __syncthreads();
}

__device__ __forceinline__ void small_gemm(LAS unsigned char* lds, const bf16_t* A, const bf16_t* Bt, bf16_t* O, int K, float scale, int bx, int G, int tid) {
    LAS float* red = (LAS float*)lds;
    const int lane = tid & 63, wave = tid >> 6, r = lane & 31, h = lane >> 5;
    const int kw = K / 8, nch = kw / 32;
    LAS unsigned char* sl = lds + 65536 + wave * 7680;
    const int lr = lane >> 2, lp = lane & 3;
    for (int tile = bx; tile < 256; tile += G) {
        const int row0 = (tile >> 5) * 64, col0 = (tile & 31) * 32;
        const bf16_t* ap = A + (size_t)(row0 + lr) * K + wave * kw + 8 * lp;
        const bf16_t* bp = Bt + (size_t)(col0 + lr) * K + wave * kw + 8 * lp;
        u32x4 ar[4], br[2];
#pragma unroll
        for (int i = 0; i < 4; ++i) ar[i] = *(const u32x4*)(ap + (size_t)(16 * i) * K);
#pragma unroll
        for (int i = 0; i < 2; ++i) br[i] = *(const u32x4*)(bp + (size_t)(16 * i) * K);
        f32x16 acc0, acc1;
#pragma unroll
        for (int i = 0; i < 16; ++i) { acc0[i] = 0.f; acc1[i] = 0.f; }
        for (int ch = 0; ch < nch; ++ch) {
#pragma unroll
            for (int i = 0; i < 4; ++i) *(LAS u32x4*)(sl + (lr + 16 * i) * 80 + 16 * lp) = ar[i];
#pragma unroll
            for (int i = 0; i < 2; ++i) *(LAS u32x4*)(sl + 5120 + (lr + 16 * i) * 80 + 16 * lp) = br[i];
            if (ch + 1 < nch) {
#pragma unroll
                for (int i = 0; i < 4; ++i) ar[i] = *(const u32x4*)(ap + (size_t)(16 * i) * K + 32 * (ch + 1));
#pragma unroll
                for (int i = 0; i < 2; ++i) br[i] = *(const u32x4*)(bp + (size_t)(16 * i) * K + 32 * (ch + 1));
            }
#pragma unroll
            for (int ks = 0; ks < 2; ++ks) {
                const bf16x8 fb = *(const LAS bf16x8*)(sl + 5120 + r * 80 + (16 * ks + 8 * h) * 2);
                acc0 = MFMA32(*(const LAS bf16x8*)(sl + r * 80 + (16 * ks + 8 * h) * 2), fb, acc0);
                acc1 = MFMA32(*(const LAS bf16x8*)(sl + (32 + r) * 80 + (16 * ks + 8 * h) * 2), fb, acc1);
            }
        }
#pragma unroll
        for (int i = 0; i < 16; ++i) { red[((wave * 2 + 0) * 16 + i) * 64 + lane] = acc0[i]; red[((wave * 2 + 1) * 16 + i) * 64 + lane] = acc1[i]; }
        __syncthreads();
#pragma unroll
        for (int j = 0; j < 4; ++j) { const int e = tid + 512 * j, le = e & 63, ie = (e >> 6) & 15, mh = e >> 10; float sum = 0.f;
#pragma unroll
            for (int w = 0; w < 8; ++w) sum += red[((w * 2 + mh) * 16 + ie) * 64 + le];
            O[(size_t)(row0 + 32 * mh + crow(ie, le >> 5)) * 1024 + col0 + (le & 31)] = f2bf(sum * scale); }
        __syncthreads();
    }
}
#define XB_TMO      128
#define XB_XCNT(j)  (256  + 64 * (j))
#define XB_XSUB(j)  (1280 + 64 * (j))
#define XB_XGEN(j)  (2304 + 64 * (j))
#define XB_TOP      3328
#define XB_TOPGEN   3392
#define XCD_BAR_WORDS 3456
#define XB_SPIN_CAP (1u << 18)

__device__ __forceinline__ unsigned xb_ld(unsigned* p)              { return __hip_atomic_load(p, __ATOMIC_RELAXED, __HIP_MEMORY_SCOPE_AGENT); }
__device__ __forceinline__ unsigned xb_add(unsigned* p, unsigned v) { return __hip_atomic_fetch_add(p, v, __ATOMIC_RELAXED, __HIP_MEMORY_SCOPE_AGENT); }
__device__ __forceinline__ unsigned xb_xcc_id() { return (unsigned)__builtin_amdgcn_s_getreg((3 << 11) | 20) & 0xFu; }
#define XB_SPIN(cond, bar) do { unsigned _sp = 0; while (cond) { __builtin_amdgcn_s_sleep(1); \
    if ((++_sp & 255u) == 0u) { if (xb_ld(&(bar)[XB_TMO])) break; if (_sp > XB_SPIN_CAP) { atomicAdd(&(bar)[XB_TMO], 1u); break; } } } } while (0)

struct XcdBarrier {
    unsigned* bar; unsigned x;
    volatile LAS unsigned* st;
};

__device__ __forceinline__ XcdBarrier xcd_barrier_post(unsigned* bar, volatile LAS unsigned* st) {
    XcdBarrier b; b.bar = bar; b.x = xb_xcc_id(); b.st = st;
    if (threadIdx.x == 0) (void)xb_add(&bar[XB_XCNT(b.x)], 1u);
    return b;
}
__device__ __forceinline__ void xcd_barrier_complete(unsigned* bar, unsigned x, unsigned& nloc, unsigned& nx) {
    const unsigned G = gridDim.x * gridDim.y * gridDim.z;
    unsigned sum, cnt, mine, sp = 0u;
    for (;;) {
        sum = 0u; cnt = 0u; mine = 0u;
#pragma unroll
        for (unsigned j = 0; j < 16; ++j) { const unsigned c = xb_ld(&bar[XB_XCNT(j)]); sum += c; cnt += (c > 0u) ? 1u : 0u; mine = (j == x) ? c : mine; }
        if (sum == G) break;
        __builtin_amdgcn_s_sleep(1);
        if ((++sp & 255u) == 0u) { if (xb_ld(&bar[XB_TMO])) break; if (sp > XB_SPIN_CAP) { atomicAdd(&bar[XB_TMO], 1u); break; } }
    }
    nloc = mine > 0u ? mine : 1u; nx = cnt > 0u ? cnt : 1u;
}

__device__ __forceinline__ void xcd_barrier(const XcdBarrier& b) {
    asm volatile("s_waitcnt vmcnt(0)" ::: "memory");
    __syncthreads();
    if (threadIdx.x == 0) {
        unsigned* bar = b.bar;
        __builtin_amdgcn_s_waitcnt(0);
        unsigned nloc = b.st[0], nx = b.st[1];
        if (nloc == 0u) { xcd_barrier_complete(bar, b.x, nloc, nx); b.st[0] = nloc; b.st[1] = nx; }
        const unsigned old = xb_add(&bar[XB_XSUB(b.x)], 1u);
        const unsigned gen = old / nloc;
        if (old + 1u == (gen + 1u) * nloc) {
            __builtin_amdgcn_fence(__ATOMIC_RELEASE, "agent");
            asm volatile("s_waitcnt vmcnt(0)" ::: "memory");
            const unsigned og = xb_add(&bar[XB_TOP], 1u);
            const unsigned tg = og / nx;
            if (og + 1u == (tg + 1u) * nx) xb_add(&bar[XB_TOPGEN], 1u);
            else XB_SPIN(xb_ld(&bar[XB_TOPGEN]) == tg, bar);
            __builtin_amdgcn_fence(__ATOMIC_ACQUIRE, "agent");
            xb_add(&bar[XB_XGEN(b.x)], 1u);
            asm volatile("s_waitcnt vmcnt(0)" ::: "memory");
        } else {
            XB_SPIN(xb_ld(&bar[XB_XGEN(b.x)]) == gen, bar);
            __builtin_amdgcn_fence(__ATOMIC_ACQUIRE, "agent");
            asm volatile("s_waitcnt vmcnt(0)" ::: "memory");
        }
    }
    __syncthreads();
}

#ifndef PHMASK
#define PHMASK 0xFFFF
#endif
#define PH(n) (((PHMASK) >> (n)) & 1)
#ifndef DBLMASK
#define DBLMASK 0
#endif
#define NREP(n) ((((DBLMASK) >> (n)) & 1) ? 2 : 1)
__global__ void __launch_bounds__(NTHREADS) fwd_megakernel(Params P) {
    extern __shared__ __attribute__((aligned(16))) unsigned char lds_raw[];
    LAS unsigned char* lds = (LAS unsigned char*)lds_raw;
    cg::grid_group grid = cg::this_grid();
    volatile LAS unsigned* bst = (volatile LAS unsigned*)(lds + LDS_BYTES - 64);
    if (threadIdx.x < 2) bst[threadIdx.x] = 0u;
    __syncthreads();
    const XcdBarrier xbar = xcd_barrier_post((unsigned*)(P.ws + 16384), bst);
#define GRID_BAR() xcd_barrier(xbar)
    if (P.ws == nullptr) grid.sync();
    const int G = gridDim.x, bx = blockIdx.x;
    const int NGW = G * NWAVES, NGT = G * NTHREADS;
#define LOCALS int tid = threadIdx.x; asm volatile("" : "+v"(tid)); const int lane = tid & 63, wave = __builtin_amdgcn_readfirstlane(tid >> 6); \
    const int gw = bx * NWAVES + wave, gt = bx * NTHREADS + tid; (void)lane; (void)gw; (void)gt;
#define WSPTRS __attribute__((address_space(1))) unsigned char* wsg_ = (__attribute__((address_space(1))) unsigned char*)P.ws; asm volatile("" : "+s"(wsg_)); unsigned char* ws = (unsigned char*)wsg_; __attribute__((address_space(1))) float* outg_ = (__attribute__((address_space(1))) float*)P.out; asm volatile("" : "+s"(outg_)); float* out = (float*)outg_; bf16_t* WinT = (bf16_t*)(ws + WS_WIN); bf16_t* WoT = (bf16_t*)(ws + WS_WO); bf16_t* WmqT = (bf16_t*)(ws + WS_WMQ); bf16_t* WmkvT = (bf16_t*)(ws + WS_WMKV); bf16_t* WmoT = (bf16_t*)(ws + WS_WMO); bf16_t* WguT = (bf16_t*)(ws + WS_WGU); bf16_t* WdT = (bf16_t*)(ws + WS_WD); bf16_t* MN = (bf16_t*)(ws + WS_MN); bf16_t* KMP = (bf16_t*)(ws + WS_KMP); bf16_t* VMTP = (bf16_t*)(ws + WS_VMTP); bf16_t* KMS = (bf16_t*)(ws + WS_KMS); bf16_t* VMTS = (bf16_t*)(ws + WS_VMTS); bf16_t* H = (bf16_t*)(ws + WS_H); bf16_t* Y = (bf16_t*)(ws + WS_Y); bf16_t* U = (bf16_t*)(ws + WS_U); float* DS = (float*)(ws + WS_DS); float* DEC = (float*)(ws + WS_DEC); bf16_t* QA = (bf16_t*)(ws + WS_QA); bf16_t* KP = (bf16_t*)(ws + WS_KP); bf16_t* VPT = (bf16_t*)(ws + WS_VPT); bf16_t* KS = (bf16_t*)(ws + WS_KS); bf16_t* VST = (bf16_t*)(ws + WS_VST); bf16_t* QB = (bf16_t*)(ws + WS_QB); bf16_t* KB = (bf16_t*)(ws + WS_KB); bf16_t* VB = (bf16_t*)(ws + WS_VB); bf16_t* RS = (bf16_t*)(ws + WS_RS); float* LA = (float*)(ws + WS_LA); bf16_t* HID = (bf16_t*)(ws + WS_HID); bf16_t* X1 = (bf16_t*)(ws + WS_R); bf16_t* X2 = (bf16_t*)(ws + WS_Y); bf16_t* KBT = (bf16_t*)(ws + WS_KBT); bf16_t* VBS = (bf16_t*)(ws + WS_VBS); float* LAS_ = (float*)(ws + WS_LAS); float* BC = (float*)(ws + WS_BC); bf16_t* SST = (bf16_t*)(ws + WS_SST); bf16_t* BT1 = (bf16_t*)(ws + WS_BT1); bf16_t* BT2 = (bf16_t*)(ws + WS_BT2); bf16_t* WMQN = (bf16_t*)(ws + WS_WMQN); bf16_t* VMN = (bf16_t*)(ws + WS_VMN);
    for (int rep_ = 0; rep_ < NREP(0); ++rep_) {
    if constexpr (PH(0)) { WSPTRS
        LOCALS
        LAS float* scr = (LAS float*)(lds + wave * 16384);
        constexpr int C1 = 16 * 80, C2 = 16 * 16, C3 = 16 * 32, C8 = 16 * 88, C10 = 44 * 32, C11 = 128 * 16, C12 = 64 * 32;
        constexpr int NITEMS = C1 + C2 + 5 * C3 + 2 * C8 + C10 + C11 + C12;
        for (int it = gw; it < NITEMS; it += NGW) {
            int r = it;
            if (r < C1) { tr_item(P.in[I_WIN], 3088, WinT, 1024, 64 * (r / 80), 32 * (r % 80), 32 * (r % 80), scr, lane); continue; } r -= C1;
            if (r < C2) { tr_item(P.in[I_WIN] + 2576, 3088, WinT, 1024, 64 * (r / 16), 32 * (r % 16), 2560 + 32 * (r % 16), scr, lane); continue; } r -= C2;
            if (r < C3) { tr_item(P.in[I_WO], 1024, WoT, 1024, 64 * (r / 32), 32 * (r % 32), 32 * (r % 32), scr, lane); continue; } r -= C3;
            if (r < C3) { tr_item(P.in[I_WMQ], 1024, WmqT, 1024, 64 * (r / 32), 32 * (r % 32), 32 * (r % 32), scr, lane); continue; } r -= C3;
            if (r < C3) { tr_item(P.in[I_WMK], 1024, WmkvT, 1024, 64 * (r / 32), 32 * (r % 32), 32 * (r % 32), scr, lane); continue; } r -= C3;
            if (r < C3) { tr_item(P.in[I_WMV], 1024, WmkvT, 1024, 64 * (r / 32), 32 * (r % 32), 1024 + 32 * (r % 32), scr, lane); continue; } r -= C3;
            if (r < C3) { tr_item(P.in[I_WMO], 1024, WmoT, 1024, 64 * (r / 32), 32 * (r % 32), 32 * (r % 32), scr, lane); continue; } r -= C3;
            if (r < C8) { const int n0 = 32 * (r % 88); tr_item(P.in[I_WG], DFF, WguT, 1024, 64 * (r / 88), n0, (n0 >> 7) * 256 + (n0 & 127), scr, lane); continue; } r -= C8;
            if (r < C8) { const int n0 = 32 * (r % 88); tr_item(P.in[I_WU], DFF, WguT, 1024, 64 * (r / 88), n0, (n0 >> 7) * 256 + 128 + (n0 & 127), scr, lane); continue; } r -= C8;
            if (r < C10) { tr_item(P.in[I_WDN], 1024, WdT, DFF, 64 * (r / 32), 32 * (r % 32), 32 * (r % 32), scr, lane); continue; } r -= C10;
            if (r < C11) { const int bh = r >> 4, q = r & 15, b = bh >> 3, hh = bh & 7;
                tr_item(P.in[I_CAV] + (size_t)b * 512 * 512 + hh * 64, 512, VST + (size_t)bh * 64 * 544, 544, 64 * (q >> 1), 32 * (q & 1), 32 * (q & 1), scr, lane); continue; } r -= C11;
            { const int bh = r >> 5, q = r & 31, b = bh >> 2, hh = bh & 3;
                tr_item(P.in[I_CMV] + (size_t)b * 256 * 1024 + hh * 256, 1024, VMTS + (size_t)bh * 256 * 256, 256, 64 * (q >> 3), 32 * (q & 7), 32 * (q & 7), scr, lane); }
        }
        for (int idx = gt; idx < 256 * 1024; idx += NGT) { const int n = idx >> 10, k = idx & 1023; const float* wr_ = P.in[I_WIN] + (size_t)k * 3088 + 2560; const float* a2 = P.in[I_WA2] + n;
            float s = 0.f;
#pragma unroll
            for (int q4 = 0; q4 < 4; ++q4) { const f32x4 w4 = *(const f32x4*)(wr_ + 4 * q4);
                s += (w4[0] * a2[(4 * q4) * 256] + w4[1] * a2[(4 * q4 + 1) * 256]) + (w4[2] * a2[(4 * q4 + 2) * 256] + w4[3] * a2[(4 * q4 + 3) * 256]); }
            WinT[(size_t)(3072 + n) * 1024 + k] = f2bf(s); }
        for (int idx = gt; idx < 1024 * 1024 / 4; idx += NGT) st_bf4(WMQN + (size_t)idx * 4, *(const f32x4*)(P.in[I_WMQ] + (size_t)idx * 4));
        for (int idx = gt; idx < NBS * 512 * 512 / 4; idx += NGT) { const int e = idx * 4, b = e >> 18, rem = e & 262143, t = rem >> 9, c = rem & 511;
            st_bf4(KS + ((size_t)b * 544 + t) * 512 + c, __builtin_nontemporal_load((const f32x4*)(P.in[I_CAK] + e))); }
        for (int idx = gt; idx < NBS * 256 * 1024 / 4; idx += NGT) st_bf4(KMS + (size_t)idx * 4, __builtin_nontemporal_load((const f32x4*)(P.in[I_CMK] + (size_t)idx * 4)));
        f32x4 gmix[2][2], gmem[2][2];
#pragma unroll
        for (int j = 0; j < 2; ++j)
#pragma unroll
            for (int hf = 0; hf < 2; ++hf) { gmix[j][hf] = *(const f32x4*)(P.in[I_GPREMIX] + 512 * j + 8 * lane + 4 * hf); gmem[j][hf] = *(const f32x4*)(P.in[I_GMEM] + 512 * j + 8 * lane + 4 * hf); }
        { int m = gw;
          for (; m + 3 * NGW < MT; m += 4 * NGW) {
              const float* const xr[4] = {xrow_ptr(P.in[I_XP], P.in[I_XS], m), xrow_ptr(P.in[I_XP], P.in[I_XS], m + NGW), xrow_ptr(P.in[I_XP], P.in[I_XS], m + 2 * NGW), xrow_ptr(P.in[I_XP], P.in[I_XS], m + 3 * NGW)};
              bf16_t* const orw[4] = {H + (size_t)m * DM, H + (size_t)(m + NGW) * DM, H + (size_t)(m + 2 * NGW) * DM, H + (size_t)(m + 3 * NGW) * DM};
              rms_rows_bf16<4>(xr, gmix, orw, lane); }
          for (; m < MT; m += NGW) { const float* const xr[1] = {xrow_ptr(P.in[I_XP], P.in[I_XS], m)}; bf16_t* const orw[1] = {H + (size_t)m * DM}; rms_rows_bf16<1>(xr, gmix, orw, lane); } }
        for (int m = gw; m < 512; m += NGW) { const float* const xr[1] = {P.in[I_MEM] + (size_t)m * DM}; bf16_t* const orw[1] = {MN + (size_t)m * DM}; rms_rows_bf16<1>(xr, gmem, orw, lane); }
    }
    GRID_BAR();
    }

    for (int rep_ = 0; rep_ < NREP(1); ++rep_) {
    if constexpr (PH(1)) { WSPTRS
        pg8::Gemm g{H, WinT, MT, NIN, DM}; pg8::StaticOrder S; S.init(MT, NIN, G, bx);
        EpiIn E{ws, P.in[I_BA], out, lds + EPT_OFF};
        pg8::gemm_phase<EpiIn, pg8::StaticOrder, true, true>(lds, g, S, E);
        pg8::Gemm g2{MN, WmkvT, 512, 2048, DM}; pg8::StaticOrder S2; S2.init(512, 2048, G, (bx + 16) % G);
        EpiMem E2{KMP, VMTP, VMN, out};
        pg8::gemm_phase<EpiMem, pg8::StaticOrder, true, true>(lds, g2, S2, E2);
    }
    GRID_BAR();
    }

    if constexpr (PH(2)) { WSPTRS
        LOCALS
        LAS float* rtab = (LAS float*)lds;
        for (int i = tid; i < 8 * 640; i += NTHREADS) { const int hh = i / 640, x = i - hh * 640; int d = 576 - x; d = d < -256 ? -256 : (d > 256 ? 256 : d);
            rtab[i] = P.in[I_RELB][hh * 513 + d + 256] * LOG2E; }
        __syncthreads();
        const LAS float* rv = rtab + wave * 640; LAS unsigned char* wl = lds + BA_TAB + wave * BA_WAVE;
        for (int rep_ = 0; rep_ < NREP(2); ++rep_)
        for (int k = bx >> 3; k < 64; k += (G >> 3)) {
            const int u = (bx & 7) * 64 + k; const int b = u >> 8, nc = u & 255; const int j0 = (nc < 8 ? (8 - nc) : 0) * 64;
            const long kbase = (long)b * SEQ + (long)(nc - 8) * 64; const size_t qrow = (size_t)b * SEQ + nc * 64;
            band_core64(QA + qrow * 512 + wave * 64, KP + kbase * 512 + wave * 64, 512, VPT + ((long)(b * 8 + wave) * 64) * SEQ + (long)(nc - 8) * 64, SEQ, j0, 576,
                        rv, Y + qrow * 1024 + wave * 64, wl, lane);
        }
        __syncthreads();
        for (int rep_ = 0; rep_ < NREP(14); ++rep_)
        for (int u = gw; u < NBP * NCH * 4; u += NGW) gla_wave_a(lds + wave * GA_WAVE, LA, KBT, VB, BC, DS, DEC, u, lane);
    }
    GRID_BAR();

    for (int rep_ = 0; rep_ < NREP(3); ++rep_) {
    if constexpr (PH(3)) { WSPTRS LOCALS
      if (bx < 128) {
        const int g = bx * 512 + tid;
        if (g < 8 * 8192) { const int seq = g >> 13, e = g & 8191, dk = e & 63, dv = e >> 6; float S = 0.f;
            const float* ds = DS + (size_t)seq * NCH * 8192 + e; const float* dc = DEC + (size_t)seq * NCH * 64 + dk; bf16_t* st = SST + (size_t)seq * NCH * 8192 + e;
            for (int c0 = 0; c0 < NCH; c0 += 32) { float dvv[32], de[32];
#pragma unroll
                for (int i = 0; i < 32; ++i) { dvv[i] = __builtin_nontemporal_load(ds + (size_t)(c0 + i) * 8192); de[i] = dc[(c0 + i) * 64]; }
#pragma unroll
                for (int i = 0; i < 32; ++i) { st[(size_t)(c0 + i) * 8192] = f2bf(S); S = de[i] * S + dvv[i]; } }
            out[OUT_PGLA + (size_t)seq * 8192 + dk * 128 + dv] = S; }

      } else if (bx < 128 + NBS) {
        LAS float* rtab = (LAS float*)lds;
        for (int i = tid; i < 8 * 640; i += NTHREADS) { const int hh = i / 640, x = i - hh * 640; int d = 576 - x; d = d < -256 ? -256 : (d > 256 ? 256 : d);
            rtab[i] = P.in[I_RELB][hh * 513 + d + 256] * LOG2E; }
        __syncthreads();
        const int b = bx - 128; const size_t qrow = (size_t)MP + b * TS;
        band_core(QA + qrow * 512 + wave * 64, KS + (size_t)b * 544 * 512 + wave * 64, 512, VST + ((size_t)(b * 8 + wave) * 64) * 544, 544, 0, 544,
                  rtab + wave * 640, 512, Y + qrow * 1024 + wave * 64, lds + BA_TAB + wave * BA_WAVE, lane);
      } else if (bx >= G - 64) { const int u = G - 1 - bx; gla_sample_unit(lds, LAS_, QB, KB, VBS, RS, P.in[I_SGLA], P.in[I_GGLA], Y, out + OUT_SGLA, u >> 2, u & 3, tid); }
    }
    GRID_BAR();
    }

    for (int rep_ = 0; rep_ < NREP(4); ++rep_) {
    if constexpr (PH(4)) { WSPTRS LOCALS for (int u = gw; u < NBP * NCH * 4; u += NGW) gla_wave_b(lds + wave * GB_WAVE, BC, QB, KB, VB, SST, RS, P.in[I_GGLA], Y, u, lane);
        for (int t = gw; t < 4096; t += NGW) { const int job = t >> 11, tt = t & 2047, nh = tt >> 8, n = nh >> 2, hh = nh & 3, ti = tt & 255;
            if (job == 0) { const int kt = ti >> 5, ct = ti & 31;
                pre_tile(KMP + ((size_t)n * 256 + 32 * kt) * 1024 + hh * 256, 1024, WMQN + (size_t)(32 * ct) * 1024 + hh * 256, 1024, BT1 + ((size_t)(n * 4 + hh) * 256 + 32 * kt) * 1024 + 32 * ct, 1024, 0.0625f * LOG2E, lane); }
            else { const int ct = ti >> 3, kt = ti & 7;
                pre_tile(WmoT + (size_t)(32 * ct) * 1024 + hh * 256, 1024, VMN + ((size_t)n * 256 + 32 * kt) * 1024 + hh * 256, 1024, BT2 + ((size_t)n * 1024 + 32 * ct) * 1024 + hh * 256 + 32 * kt, 1024, 1.f, lane); } }
    }
    GRID_BAR();
    }

    for (int rep_ = 0; rep_ < NREP(5); ++rep_) {
    if constexpr (PH(5)) { WSPTRS pg8::Gemm g{Y, WoT, MP, DM, DM}; pg8::StaticOrder S; S.init(MP, DM, G, bx); EpiPlain E{U, DM, 1.f};
      pg8::gemm_phase<EpiPlain, pg8::StaticOrder, true, true>(lds, g, S, E);
      LOCALS small_gemm(lds, Y + (size_t)MP * DM, WoT, U + (size_t)MP * DM, DM, 1.f, bx, G, tid); }
    GRID_BAR();
    }
    for (int rep_ = 0; rep_ < NREP(6); ++rep_) {
    if constexpr (PH(6)) { WSPTRS LOCALS
        int m = gw; const RowGains RG = load_gains(P.in[I_GPOSTMIX], P.in[I_GPREMEM], lane);
        for (; m + 3 * NGW < MT; m += 4 * NGW) { const bf16_t* const ur[4] = {U + (size_t)(m) * DM, U + (size_t)(m + 1 * NGW) * DM, U + (size_t)(m + 2 * NGW) * DM, U + (size_t)(m + 3 * NGW) * DM}; const void* const xi[4] = {(const void*)xrow_ptr(P.in[I_XP], P.in[I_XS], m), (const void*)xrow_ptr(P.in[I_XP], P.in[I_XS], m + 1 * NGW), (const void*)xrow_ptr(P.in[I_XP], P.in[I_XS], m + 2 * NGW), (const void*)xrow_ptr(P.in[I_XP], P.in[I_XS], m + 3 * NGW)};
            void* const xo[4] = {(void*)(X1 + (size_t)(m) * DM), (void*)(X1 + (size_t)(m + 1 * NGW) * DM), (void*)(X1 + (size_t)(m + 2 * NGW) * DM), (void*)(X1 + (size_t)(m + 3 * NGW) * DM)}; bf16_t* const ho[4] = {H + (size_t)(m) * DM, H + (size_t)(m + 1 * NGW) * DM, H + (size_t)(m + 2 * NGW) * DM, H + (size_t)(m + 3 * NGW) * DM};
            rowpass_rows<4, false, true>(ur, xi, RG, xo, ho, lane); }
        for (; m < MT; m += NGW) { const bf16_t* const ur[1] = {U + (size_t)(m) * DM}; const void* const xi[1] = {(const void*)xrow_ptr(P.in[I_XP], P.in[I_XS], m)}; void* const xo[1] = {(void*)(X1 + (size_t)(m) * DM)}; bf16_t* const ho[1] = {H + (size_t)(m) * DM};
            rowpass_rows<1, false, true>(ur, xi, RG, xo, ho, lane); } }
    GRID_BAR();
    }
    for (int rep_ = 0; rep_ < NREP(7); ++rep_) {
    if constexpr (PH(7)) { WSPTRS pg8::Gemm g{H, BT1, MP, DM, DM}; OrderMem S; S.S.init(MP, DM, G, bx); EpiSoftmax E{U, lds + EPT_OFF};
      pg8::gemm_phase<EpiSoftmax, OrderMem, true, true>(lds, g, S, E);
      LOCALS small_gemm(lds, H + (size_t)MP * DM, WmqT, U + (size_t)MP * DM, DM, 0.0625f * LOG2E, bx, G, tid); }
    GRID_BAR();
    }
    for (int rep_ = 0; rep_ < NREP(8); ++rep_) {
    if constexpr (PH(8)) { WSPTRS LOCALS
        for (int item = bx; item < NBS * 4; item += G) {
            const int b = item >> 2, hh = item & 3; const size_t row0 = (size_t)MP + (size_t)b * TS;
            mem_attn_item(lds, KMS + (size_t)b * 256 * 1024 + hh * 256, VMTS + (size_t)(b * 4 + hh) * 65536, U + row0 * 1024 + hh * 256, Y + row0 * 1024 + hh * 256, 1, tid);
        }
    }
    GRID_BAR();
    }
    for (int rep_ = 0; rep_ < NREP(9); ++rep_) {
    if constexpr (PH(9)) { WSPTRS pg8::Gemm g{U, BT2, MP, DM, DM}; OrderMem S; S.S.init(MP, DM, G, bx); EpiPlainM E{Y};
      pg8::gemm_phase<EpiPlainM, OrderMem, true, true>(lds, g, S, E);
      LOCALS small_gemm(lds, Y + (size_t)MP * DM, WmoT, U + (size_t)MP * DM, DM, 1.f, bx, G, tid); }
    GRID_BAR();
    }
    if constexpr (PH(10)) { WSPTRS LOCALS
        int m = gw; const RowGains RG = load_gains(P.in[I_GPOSTMEM], P.in[I_GPREFFN], lane);
        for (; m + 3 * NGW < MT; m += 4 * NGW) { const bf16_t* const ur[4] = {((m) < MP ? Y : U) + (size_t)(m) * DM, ((m + 1 * NGW) < MP ? Y : U) + (size_t)(m + 1 * NGW) * DM, ((m + 2 * NGW) < MP ? Y : U) + (size_t)(m + 2 * NGW) * DM, ((m + 3 * NGW) < MP ? Y : U) + (size_t)(m + 3 * NGW) * DM}; const void* const xi[4] = {(const void*)(X1 + (size_t)(m) * DM), (const void*)(X1 + (size_t)(m + 1 * NGW) * DM), (const void*)(X1 + (size_t)(m + 2 * NGW) * DM), (const void*)(X1 + (size_t)(m + 3 * NGW) * DM)};
            void* const xo[4] = {(void*)(X2 + (size_t)(m) * DM), (void*)(X2 + (size_t)(m + 1 * NGW) * DM), (void*)(X2 + (size_t)(m + 2 * NGW) * DM), (void*)(X2 + (size_t)(m + 3 * NGW) * DM)}; bf16_t* const ho[4] = {H + (size_t)(m) * DM, H + (size_t)(m + 1 * NGW) * DM, H + (size_t)(m + 2 * NGW) * DM, H + (size_t)(m + 3 * NGW) * DM};
            rowpass_rows<4, true, true>(ur, xi, RG, xo, ho, lane); }
        for (; m < MT; m += NGW) { const bf16_t* const ur[1] = {((m) < MP ? Y : U) + (size_t)(m) * DM}; const void* const xi[1] = {(const void*)(X1 + (size_t)(m) * DM)}; void* const xo[1] = {(void*)(X2 + (size_t)(m) * DM)}; bf16_t* const ho[1] = {H + (size_t)(m) * DM};
            rowpass_rows<1, true, true>(ur, xi, RG, xo, ho, lane); } }
    GRID_BAR();
    for (int rep_ = 0; rep_ < NREP(11); ++rep_) {
    if constexpr (PH(11)) { WSPTRS pg8::Gemm g{H, WguT, MT, 2 * DFF, DM}; pg8::StaticOrder S; S.init(MT, 2 * DFF, G, bx); EpiSwiglu E{HID};
      pg8::gemm_phase<EpiSwiglu, pg8::StaticOrder, true, true>(lds, g, S, E); }
    GRID_BAR();
    }
    for (int rep_ = 0; rep_ < NREP(12); ++rep_) {
    if constexpr (PH(12)) { WSPTRS pg8::Gemm g{HID, WdT, MP, DM, DFF}; pg8::StaticOrder S; S.init(MP, DM, G, bx); EpiPlain E{U, DM, 1.f};
      pg8::gemm_phase<EpiPlain, pg8::StaticOrder, true, true>(lds, g, S, E);
      LOCALS small_gemm(lds, HID + (size_t)MP * DFF, WdT, U + (size_t)MP * DM, DFF, 1.f, bx, G, tid); }
    GRID_BAR();
    }
    if constexpr (PH(13)) { WSPTRS LOCALS
        int m = gw; const RowGains RG = load_gains(P.in[I_GPOSTFFN], (const float*)nullptr, lane);
        for (; m + 3 * NGW < MT; m += 4 * NGW) { const bf16_t* const ur[4] = {U + (size_t)(m) * DM, U + (size_t)(m + 1 * NGW) * DM, U + (size_t)(m + 2 * NGW) * DM, U + (size_t)(m + 3 * NGW) * DM}; const void* const xi[4] = {(const void*)(X2 + (size_t)(m) * DM), (const void*)(X2 + (size_t)(m + 1 * NGW) * DM), (const void*)(X2 + (size_t)(m + 2 * NGW) * DM), (const void*)(X2 + (size_t)(m + 3 * NGW) * DM)};
            void* const xo[4] = {(void*)(out + (size_t)(m) * DM), (void*)(out + (size_t)(m + 1 * NGW) * DM), (void*)(out + (size_t)(m + 2 * NGW) * DM), (void*)(out + (size_t)(m + 3 * NGW) * DM)}; bf16_t* const ho[4] = {H + (size_t)(m) * DM, H + (size_t)(m + 1 * NGW) * DM, H + (size_t)(m + 2 * NGW) * DM, H + (size_t)(m + 3 * NGW) * DM};
            rowpass_rows<4, true, false>(ur, xi, RG, xo, ho, lane); }
        for (; m < MT; m += NGW) { const bf16_t* const ur[1] = {U + (size_t)(m) * DM}; const void* const xi[1] = {(const void*)(X2 + (size_t)(m) * DM)}; void* const xo[1] = {(void*)(out + (size_t)(m) * DM)}; bf16_t* const ho[1] = {H + (size_t)(m) * DM};
            rowpass_rows<1, true, false>(ur, xi, RG, xo, ho, lane); } }
}

extern "C" void kernel_launch(void* const* d_in, const int* in_sizes, int n_in, void* d_out, int out_size, void* d_ws, size_t ws_size, hipStream_t stream) {
    static int grid = 0;
    if (grid == 0) {
        if (n_in != 28 || (size_t)out_size != OUT_TOTAL || ws_size < WS_END) { fprintf(stderr, "kernel_launch: unexpected problem shape (n_in %d, out %d, ws %zu)\n", n_in, out_size, ws_size); grid = -1; return; }
        int dev = 0, cus = 0, per_cu = 0;
        hipGetDevice(&dev); hipDeviceGetAttribute(&cus, hipDeviceAttributeMultiprocessorCount, dev);
        hipFuncSetAttribute((const void*)fwd_megakernel, hipFuncAttributeMaxDynamicSharedMemorySize, LDS_BYTES);
        hipOccupancyMaxActiveBlocksPerMultiprocessor(&per_cu, (const void*)fwd_megakernel, NTHREADS, LDS_BYTES);
        if (per_cu < 1) { fprintf(stderr, "kernel_launch: occupancy query reports %d blocks per CU\n", per_cu); per_cu = 1; }
        grid = cus;
    }
    if (grid < 0) return;
    if (hipMemsetAsync(d_ws, 0, 65536, stream) != hipSuccess) { fprintf(stderr, "kernel_launch: memset of the barrier words failed\n"); return; }
    Params p{};
    for (int i = 0; i < 28; ++i) p.in[i] = (const float*)d_in[i];
    p.out = (float*)d_out; p.ws = (unsigned char*)d_ws;
    void* args[] = {&p};
    hipError_t e = hipLaunchCooperativeKernel((const void*)fwd_megakernel, dim3(grid), dim3(NTHREADS), args, LDS_BYTES, stream);
    if (e != hipSuccess) fprintf(stderr, "cooperative launch failed: %s (grid %d)\n", hipGetErrorString(e), grid);
}
```
